# Optimizing an MI355X kernel written in HIP

```python
import math
import jax, jax.numpy as jnp
from jax import lax
import numpy as np

D_MODEL = 1024
BATCH = 8
SEQ = 2048
DEPTH = 4
DEC_BATCH = 128
DEC_SEQ = 4
PAST_LEN = 16384
PAGE_SIZE = 128

N_EVEN = (DEPTH + 1) // 2
N_ODD = DEPTH // 2
D_A = D_MODEL // 2
CONV_W = 31
D_B = D_MODEL // 2
POOL_WINDOWS = (2, 4, 8, 16)
N_POOL_GROUPS = len(POOL_WINDOWS)
POOL_G = D_B // N_POOL_GROUPS
MAX_WIN = max(POOL_WINDOWS)
D_C = D_MODEL
H_C = 8
DH_C = D_C // H_C
CHUNK = 128
D_FF = 4 * D_MODEL
N_MOD = 6
EPS = 1e-6

kernel_name = "hybrid_conv_pool_gmlp_decoder_step"


def rmsnorm(x, g):
    xf = x.astype(jnp.float32)
    y = xf * lax.rsqrt(jnp.mean(xf * xf, axis=-1, keepdims=True) + EPS)
    return (y * g.astype(jnp.float32)).astype(x.dtype)


def layernorm(x, g, b):
    xf = x.astype(jnp.float32)
    mu = jnp.mean(xf, axis=-1, keepdims=True)
    xc = xf - mu
    var = jnp.mean(xc * xc, axis=-1, keepdims=True)
    y = xc * lax.rsqrt(var + EPS) * g.astype(jnp.float32) + b.astype(jnp.float32)
    return y.astype(x.dtype)


def adaln(c, w_ada, b_ada):
    mod = jax.nn.silu(c) @ w_ada + b_ada
    mod = mod.reshape(c.shape[0], N_MOD, D_MODEL)[:, :, None, :]
    return [mod[:, i] for i in range(N_MOD)]


def even_mixer(h, conv_hist, pool_hist, pos0, w_in, w_dw, b_dw, g_cln, b_cln, w_pool, s_pool, w_out):
    T = h.shape[1]
    z = h @ w_in
    a_val, a_gate, p_in = z[..., :D_A], z[..., D_A:2 * D_A], z[..., 2 * D_A:]
    a = a_val * jax.nn.sigmoid(a_gate)
    a_ext = jnp.concatenate([conv_hist.astype(a.dtype), a], axis=1)
    conv = lax.conv_general_dilated(
        a_ext, w_dw[:, None, :], window_strides=(1,), padding='VALID',
        dimension_numbers=('NWC', 'WIO', 'NWC'), feature_group_count=D_A) + b_dw
    a_out = jax.nn.silu(layernorm(conv, g_cln, b_cln))
    P = MAX_WIN - 1
    p_ext = jnp.concatenate([pool_hist.astype(p_in.dtype), p_in], axis=1)
    cs = jnp.cumsum(p_ext.astype(jnp.float32), axis=1)
    cs = jnp.concatenate([jnp.zeros_like(cs[:, :1]), cs], axis=1)
    pos = pos0 + jnp.arange(T) + 1
    diffs = []
    for gi, w in enumerate(POOL_WINDOWS):
        sl = slice(gi * POOL_G, (gi + 1) * POOL_G)
        win_sum = cs[:, P + 1:P + 1 + T, sl] - cs[:, P + 1 - w:P + 1 - w + T, sl]
        cnt = jnp.minimum(w, pos).astype(jnp.float32)[None, :, None]
        diffs.append((win_sum / cnt).astype(p_in.dtype) - p_in[..., sl])
    d = jnp.stack(diffs, axis=2)
    b_out = jnp.einsum('btgi,gio->btgo', d, w_pool).reshape(h.shape[0], T, D_B) * s_pool
    out = jnp.concatenate([a_out, b_out], axis=-1) @ w_out
    return out, a_ext[:, -(CONV_W - 1):], p_ext[:, -(MAX_WIN - 1):]


def odd_mixer(h, w_in, g_v, b_v, w_s, b_s, w_out):
    B, T, _ = h.shape
    z = h @ w_in
    u, v = z[..., :D_C], z[..., D_C:]
    v = layernorm(v, g_v, b_v)
    L = min(T, CHUNK)
    n = T // L
    vc = v.reshape(B, n, L, H_C, DH_C)
    mask = jnp.tril(jnp.ones((CHUNK, CHUNK), dtype=w_s.dtype))
    ws = (w_s * mask)[:, :L, :L]
    s = jnp.einsum('hts,bnshd->bnthd', ws, vc) + b_s[:, :L].T[None, None, :, :, None]
    y = u * s.reshape(B, T, D_C)
    return y @ w_out, v


def trunk(x, c, conv_hist, pool_hist, pos0,
          w_ada, b_ada, g_mix, g_ffn, w_in_ab, w_dw, b_dw, g_conv_ln, b_conv_ln,
          w_pool, s_pool, w_out_ab, w_in_c, g_v_ln, b_v_ln, w_spatial, b_spatial,
          w_out_c, w_ffn1, w_ffn2, g_final):
    new_conv, new_pool, new_v = [], [], []
    for l in range(DEPTH):
        sh1, sc1, gt1, sh2, sc2, gt2 = adaln(c, w_ada[l], b_ada[l])
        h = rmsnorm(x, g_mix[l]) * (1 + sc1) + sh1
        if l % 2 == 0:
            i = l // 2
            out, ch, ph = even_mixer(h, conv_hist[i], pool_hist[i], pos0, w_in_ab[i], w_dw[i], b_dw[i],
                                     g_conv_ln[i], b_conv_ln[i], w_pool[i], s_pool[i], w_out_ab[i])
            new_conv.append(ch)
            new_pool.append(ph)
        else:
            j = l // 2
            out, vrows = odd_mixer(h, w_in_c[j], g_v_ln[j], b_v_ln[j], w_spatial[j], b_spatial[j], w_out_c[j])
            new_v.append(vrows)
        x = x + gt1 * out
        h = rmsnorm(x, g_ffn[l]) * (1 + sc2) + sh2
        f = jnp.square(jax.nn.relu(h @ w_ffn1[l])) @ w_ffn2[l]
        x = x + gt2 * f
    return rmsnorm(x, g_final), jnp.stack(new_conv), jnp.stack(new_pool), jnp.stack(new_v)


def setup_inputs(seed: int = 0) -> dict:
    key = jax.random.key(seed)
    ks = iter(jax.random.split(key, 40))
    f32 = jnp.float32
    nrm = lambda shape, s: jax.random.normal(next(ks), shape, f32) * s
    gain = lambda shape: 1.0 + nrm(shape, 0.1)
    return {
        "x_prompt": nrm((BATCH, SEQ, D_MODEL), 1.0),
        "x_sample": nrm((DEC_BATCH, DEC_SEQ, D_MODEL), 1.0),
        "c_prompt": nrm((BATCH, D_MODEL), 1.0),
        "c_sample": nrm((DEC_BATCH, D_MODEL), 1.0),
        "state_conv": nrm((N_EVEN, DEC_BATCH, CONV_W - 1, D_A), 0.5),
        "state_pool": nrm((N_EVEN, DEC_BATCH, MAX_WIN - 1, D_B), 1.0),
        "w_ada": nrm((DEPTH, D_MODEL, N_MOD * D_MODEL), 0.5 * D_MODEL ** -0.5),
        "b_ada": nrm((DEPTH, N_MOD * D_MODEL), 0.1),
        "g_mix": gain((DEPTH, D_MODEL)),
        "g_ffn": gain((DEPTH, D_MODEL)),
        "w_in_ab": nrm((N_EVEN, D_MODEL, 2 * D_A + D_B), D_MODEL ** -0.5),
        "w_dw": nrm((N_EVEN, CONV_W, D_A), CONV_W ** -0.5),
        "b_dw": nrm((N_EVEN, D_A), 0.02),
        "g_conv_ln": gain((N_EVEN, D_A)),
        "b_conv_ln": nrm((N_EVEN, D_A), 0.02),
        "w_pool": nrm((N_EVEN, N_POOL_GROUPS, POOL_G, POOL_G), POOL_G ** -0.5),
        "s_pool": gain((N_EVEN, D_B)),
        "w_out_ab": nrm((N_EVEN, D_A + D_B, D_MODEL), (D_A + D_B) ** -0.5),
        "w_in_c": nrm((N_ODD, D_MODEL, 2 * D_C), D_MODEL ** -0.5),
        "g_v_ln": gain((N_ODD, D_C)),
        "b_v_ln": nrm((N_ODD, D_C), 0.02),
        "w_spatial": nrm((N_ODD, H_C, CHUNK, CHUNK), CHUNK ** -0.5),
        "b_spatial": gain((N_ODD, H_C, CHUNK)),
        "w_out_c": nrm((N_ODD, D_C, D_MODEL), D_C ** -0.5),
        "w_ffn1": nrm((DEPTH, D_MODEL, D_FF), D_MODEL ** -0.5),
        "w_ffn2": nrm((DEPTH, D_FF, D_MODEL), D_FF ** -0.5),
        "g_final": gain((D_MODEL,)),
    }


def reference(x_prompt, x_sample, c_prompt, c_sample, state_conv, state_pool,
              w_ada, b_ada, g_mix, g_ffn, w_in_ab, w_dw, b_dw, g_conv_ln, b_conv_ln,
              w_pool, s_pool, w_out_ab, w_in_c, g_v_ln, b_v_ln, w_spatial, b_spatial,
              w_out_c, w_ffn1, w_ffn2, g_final):
    weights = (w_ada, b_ada, g_mix, g_ffn, w_in_ab, w_dw, b_dw, g_conv_ln, b_conv_ln,
               w_pool, s_pool, w_out_ab, w_in_c, g_v_ln, b_v_ln, w_spatial, b_spatial,
               w_out_c, w_ffn1, w_ffn2, g_final)
    conv0 = jnp.zeros((N_EVEN, x_prompt.shape[0], CONV_W - 1, D_A), x_prompt.dtype)
    pool0 = jnp.zeros((N_EVEN, x_prompt.shape[0], MAX_WIN - 1, D_B), x_prompt.dtype)
    y_prompt, new_conv_prompt, new_pool_prompt, _ = trunk(
        x_prompt, c_prompt, conv0, pool0, 0, *weights)
    y_sample, new_conv_sample, new_pool_sample, new_v_sample = trunk(
        x_sample, c_sample, state_conv, state_pool, PAST_LEN, *weights)
    return (y_prompt, y_sample, new_conv_prompt, new_pool_prompt,
            new_conv_sample, new_pool_sample, new_v_sample)
```

```cpp
#include <hip/hip_runtime.h>
#include <cstdio>
#include <cstdint>

constexpr int D = 1024, NB_P = 8, T_P = 2048, NB_S = 128, T_S = 4, DEPTH = 4;
constexpr int MP = NB_P * T_P, MS = NB_S * T_S, M = MP + MS;
constexpr int NMODROWS = NB_P + NB_S;
constexpr int DA = 512, DB = 512, CONVW = 31, NHIST_C = 30, NHIST_P = 15, FF = 4096, NZ_E = 1536, NZ_O = 2048;
constexpr int HC = 8, DHC = 128, CHUNK = 128, PAST = 16384;
constexpr float EPS = 1e-6f;

enum { I_XP = 0, I_XS, I_CP, I_CS, I_SCONV, I_SPOOL, I_WADA, I_BADA, I_GMIX, I_GFFN, I_WINAB, I_WDW, I_BDW, I_GCLN, I_BCLN,
       I_WPOOL, I_SPOOLS, I_WOUTAB, I_WINC, I_GV, I_BV, I_WSP, I_BSP, I_WOUTC, I_WFFN1, I_WFFN2, I_GFINAL, N_INPUTS };

constexpr size_t O_YP = 0, O_YS = O_YP + (size_t)MP * D, O_NCP = O_YS + (size_t)MS * D, O_NPP = O_NCP + (size_t)2 * NB_P * NHIST_C * DA,
                 O_NCS = O_NPP + (size_t)2 * NB_P * NHIST_P * DB, O_NPS = O_NCS + (size_t)2 * NB_S * NHIST_C * DA,
                 O_NV = O_NPS + (size_t)2 * NB_S * NHIST_P * DB, O_END = O_NV + (size_t)2 * NB_S * T_S * D;

__device__ __forceinline__ void row_info(int r, int& b, int& t, int& modrow, int& seq0, bool& samp) {
    if (r < MP) { b = r >> 11; t = r & 2047; modrow = b; seq0 = b << 11; samp = false; }
    else { const int q = r - MP; b = q >> 2; t = q & 3; modrow = NB_P + b; seq0 = MP + (b << 2); samp = true; }
}
__device__ __forceinline__ float sigmoidf_(float v) { return 1.0f / (1.0f + __expf(-v)); }
__device__ __forceinline__ float siluf_(float v) { return v / (1.0f + __expf(-v)); }

namespace naive {
__global__ void k_ada(const float* cp, const float* cs, const float* w_ada, const float* b_ada, float* mod) {
    const int n = blockIdx.x * 256 + threadIdx.x, r = blockIdx.y, l = blockIdx.z;
    const float* c = r < NB_P ? cp + (size_t)r * D : cs + (size_t)(r - NB_P) * D;
    const float* w = w_ada + (size_t)l * D * 6 * D + n;
    float acc = b_ada[(size_t)l * 6 * D + n];
    for (int k = 0; k < D; ++k) acc += siluf_(c[k]) * w[(size_t)k * 6 * D];
    mod[((size_t)l * NMODROWS + r) * 6 * D + n] = acc;
}
__global__ void k_copy_x(const float* xp, const float* xs, float* X) {
    const size_t i = (size_t)blockIdx.x * 256 + threadIdx.x;
    if (i < (size_t)M * D) X[i] = i < (size_t)MP * D ? xp[i] : xs[i - (size_t)MP * D];
}
__device__ float block_sum(float v, float* sh) {
    for (int o = 32; o > 0; o >>= 1) v += __shfl_xor(v, o);
    __syncthreads();
    if ((threadIdx.x & 63) == 0) sh[threadIdx.x >> 6] = v;
    __syncthreads();
    float s = 0.f; for (int i = 0; i < (int)(blockDim.x >> 6); ++i) s += sh[i];
    return s;
}
__global__ void k_norm(const float* X, const float* g, const float* mod_l, int i_shift, int i_scale, float* H) {
    __shared__ float sh[16];
    const int r = blockIdx.x; int b, t, mr, s0; bool sp; row_info(r, b, t, mr, s0, sp);
    const float* x = X + (size_t)r * D; float v[4]; float ss = 0.f;
    for (int j = 0; j < 4; ++j) { v[j] = x[threadIdx.x + 256 * j]; ss += v[j] * v[j]; }
    const float rstd = rsqrtf(block_sum(ss, sh) * (1.0f / D) + EPS);
    for (int j = 0; j < 4; ++j) { const int k = threadIdx.x + 256 * j; float y = v[j] * rstd * g[k];
        if (mod_l) { const float* m = mod_l + (size_t)mr * 6 * D; y = y * (1.0f + m[i_scale * D + k]) + m[i_shift * D + k]; }
        H[(size_t)r * D + k] = y; }
}
__global__ void __launch_bounds__(256) k_sgemm(const float* A, int lda, const float* W, int ldw, float* C, int ldc, int K) {
    __shared__ float As[8][128 + 4], Ws[8][128];
    const int tid = threadIdx.x, tx = tid & 15, ty = tid >> 4, m0 = blockIdx.y * 128, n0 = blockIdx.x * 128;
    float acc[8][8];
    for (int i = 0; i < 8; ++i) for (int j = 0; j < 8; ++j) acc[i][j] = 0.f;
    for (int k0 = 0; k0 < K; k0 += 8) {
        { const int row = tid >> 1, kk = (tid & 1) * 4; const float4 a = *(const float4*)(A + (size_t)(m0 + row) * lda + k0 + kk);
          As[kk + 0][row] = a.x; As[kk + 1][row] = a.y; As[kk + 2][row] = a.z; As[kk + 3][row] = a.w; }
        { const int kk = tid >> 5, col = (tid & 31) * 4; *(float4*)&Ws[kk][col] = *(const float4*)(W + (size_t)(k0 + kk) * ldw + n0 + col); }
        __syncthreads();
#pragma unroll
        for (int kk = 0; kk < 8; ++kk) {
            float a[8], w[8];
#pragma unroll
            for (int i = 0; i < 8; ++i) a[i] = As[kk][ty * 8 + i];
#pragma unroll
            for (int j = 0; j < 8; ++j) w[j] = Ws[kk][tx * 8 + j];
#pragma unroll
            for (int i = 0; i < 8; ++i)
#pragma unroll
                for (int j = 0; j < 8; ++j) acc[i][j] += a[i] * w[j];
        }
        __syncthreads();
    }
    for (int i = 0; i < 8; ++i) { float* c = C + (size_t)(m0 + ty * 8 + i) * ldc + n0 + tx * 8;
        *(float4*)c = make_float4(acc[i][0], acc[i][1], acc[i][2], acc[i][3]); *(float4*)(c + 4) = make_float4(acc[i][4], acc[i][5], acc[i][6], acc[i][7]); }
}
__device__ __forceinline__ float a_val(const float* Z, const float* hist_c  , int seq0, int b, bool samp, int tt, int c) {
    if (tt >= 0) { const float* z = Z + (size_t)(seq0 + tt) * NZ_E; return z[c] * sigmoidf_(z[DA + c]); }
    return samp ? hist_c[((size_t)b * NHIST_C + (NHIST_C + tt)) * DA + c] : 0.f;
}
__device__ __forceinline__ float p_val(const float* Z, const float* hist_p  , int seq0, int b, bool samp, int tt, int c) {
    if (tt >= 0) return Z[(size_t)(seq0 + tt) * NZ_E + 2 * DA + c];
    return samp ? hist_p[((size_t)b * NHIST_P + (NHIST_P + tt)) * DB + c] : 0.f;
}
__global__ void __launch_bounds__(512) k_even_mix(const float* Z, const float* hist_c, const float* hist_p, const float* w_dw, const float* b_dw, const float* g_cln, const float* b_cln,
                                                  const float* w_pool, const float* s_pool, float* CAT) {
    __shared__ float sh[16]; __shared__ float dsh[DB];
    const int r = blockIdx.x, c = threadIdx.x; int b, t, mr, s0; bool sp; row_info(r, b, t, mr, s0, sp);
    float conv = b_dw[c];
    for (int j = 0; j < CONVW; ++j) conv += w_dw[j * DA + c] * a_val(Z, hist_c, s0, b, sp, t - 30 + j, c);
    const float mu = block_sum(conv, sh) * (1.0f / DA); const float xc = conv - mu;
    const float var = block_sum(xc * xc, sh) * (1.0f / DA);
    const float ln = xc * rsqrtf(var + EPS) * g_cln[c] + b_cln[c];
    CAT[(size_t)r * D + c] = siluf_(ln);
    const int g = c >> 7, w = 2 << g; float s = 0.f;
    for (int k = 0; k < w; ++k) s += p_val(Z, hist_p, s0, b, sp, t - k, c);
    const int pos = (sp ? PAST : 0) + t + 1; const float cnt = (float)(w < pos ? w : pos);
    dsh[c] = s / cnt - p_val(Z, hist_p, s0, b, sp, t, c);
    __syncthreads();
    const int o = c & 127; float acc = 0.f; const float* wp = w_pool + (size_t)g * 128 * 128 + o;
    for (int i = 0; i < 128; ++i) acc += dsh[g * 128 + i] * wp[(size_t)i * 128];
    CAT[(size_t)r * D + DA + c] = acc * s_pool[c];
}
__global__ void k_states(const float* Z, const float* hist_c, const float* hist_p, float* out, int i) {
    const size_t id = (size_t)blockIdx.x * 256 + threadIdx.x;
    const size_t n_cp = (size_t)NB_P * NHIST_C * DA, n_pp = (size_t)NB_P * NHIST_P * DB, n_cs = (size_t)NB_S * NHIST_C * DA, n_ps = (size_t)NB_S * NHIST_P * DB;
    if (id < n_cp) { const int c = id % DA, j = (id / DA) % NHIST_C, b = id / (DA * NHIST_C);
        out[O_NCP + (size_t)i * n_cp + id] = a_val(Z, hist_c, b * T_P, b, false, T_P - NHIST_C + j, c); return; }
    size_t k = id - n_cp;
    if (k < n_pp) { const int c = k % DB, j = (k / DB) % NHIST_P, b = k / (DB * NHIST_P);
        out[O_NPP + (size_t)i * n_pp + k] = p_val(Z, hist_p, b * T_P, b, false, T_P - NHIST_P + j, c); return; }
    k -= n_pp;
    if (k < n_cs) { const int c = k % DA, j = (k / DA) % NHIST_C, b = k / (DA * NHIST_C);
        out[O_NCS + (size_t)i * n_cs + k] = a_val(Z, hist_c, MP + b * T_S, b, true, T_S - NHIST_C + j, c); return; }
    k -= n_cs;
    if (k < n_ps) { const int c = k % DB, j = (k / DB) % NHIST_P, b = k / (DB * NHIST_P);
        out[O_NPS + (size_t)i * n_ps + k] = p_val(Z, hist_p, MP + b * T_S, b, true, T_S - NHIST_P + j, c); }
}
__global__ void k_vln(const float* Z, const float* g_v, const float* b_v, float* VN, float* out, int j) {
    __shared__ float sh[16];
    const int r = blockIdx.x; const float* v = Z + (size_t)r * NZ_O + D; float x[4]; float s = 0.f;
    for (int q = 0; q < 4; ++q) { x[q] = v[threadIdx.x + 256 * q]; s += x[q]; }
    const float mu = block_sum(s, sh) * (1.0f / D); float s2 = 0.f;
    for (int q = 0; q < 4; ++q) { x[q] -= mu; s2 += x[q] * x[q]; }
    const float rstd = rsqrtf(block_sum(s2, sh) * (1.0f / D) + EPS);
    for (int q = 0; q < 4; ++q) { const int c = threadIdx.x + 256 * q; const float y = x[q] * rstd * g_v[c] + b_v[c];
        VN[(size_t)r * D + c] = y; if (r >= MP) out[O_NV + ((size_t)j * MS + (r - MP)) * D + c] = y; }
}
__global__ void k_spatial(const float* Z, const float* VN, const float* w_sp  , const float* b_sp  , float* Y) {
    const int r = blockIdx.x; int b, t, mr, s0; bool sp; row_info(r, b, t, mr, s0, sp);
    const int tc = sp ? t : (t & 127), chunk0 = sp ? s0 : (r - tc);
    for (int q = 0; q < 4; ++q) { const int c = threadIdx.x + 256 * q, h = c >> 7; const float* ws = w_sp + ((size_t)h * CHUNK + tc) * CHUNK;
        float acc = b_sp[h * CHUNK + tc];
        for (int s = 0; s <= tc; ++s) acc += ws[s] * VN[(size_t)(chunk0 + s) * D + c];
        Y[(size_t)r * D + c] = Z[(size_t)r * NZ_O + c] * acc; }
}
__global__ void k_resid(float* X, const float* OUT, int ldo, const float* mod_l, int i_gate, int row0) {
    const int r = row0 + blockIdx.x; int b, t, mr, s0; bool sp; row_info(r, b, t, mr, s0, sp);
    const float* gt = mod_l + (size_t)mr * 6 * D + (size_t)i_gate * D;
    for (int q = 0; q < 4; ++q) { const int c = threadIdx.x + 256 * q; X[(size_t)r * D + c] += gt[c] * OUT[(size_t)blockIdx.x * ldo + c]; }
}
__global__ void k_relu2(float* Hd, size_t n) { const size_t i = (size_t)blockIdx.x * 256 + threadIdx.x; if (i < n) { const float v = fmaxf(Hd[i], 0.f); Hd[i] = v * v; } }

static void forward(void* const* d_in, float* out, unsigned char* ws, hipStream_t st) {
    auto in = [&](int i) { return (const float*)d_in[i]; };
    constexpr size_t MiB = 1 << 20;
    float* MOD = (float*)(ws + 0);
    float* X   = (float*)(ws + 16 * MiB);
    float* H   = (float*)(ws + 84 * MiB);
    float* CAT = (float*)(ws + 152 * MiB);
    float* Z   = (float*)(ws + 220 * MiB);
    float* HID = Z; float* OUT = (float*)(ws + 220 * MiB + 68 * MiB);
    k_ada<<<dim3(6 * D / 256, NMODROWS, DEPTH), 256, 0, st>>>(in(I_CP), in(I_CS), in(I_WADA), in(I_BADA), MOD);
    k_copy_x<<<(unsigned)(((size_t)M * D + 255) / 256), 256, 0, st>>>(in(I_XP), in(I_XS), X);
    for (int l = 0; l < DEPTH; ++l) {
        const float* mod_l = MOD + (size_t)l * NMODROWS * 6 * D;
        k_norm<<<M, 256, 0, st>>>(X, in(I_GMIX) + (size_t)l * D, mod_l, 0, 1, H);
        if ((l & 1) == 0) {
            const int i = l >> 1;
            k_sgemm<<<dim3(NZ_E / 128, M / 128), 256, 0, st>>>(H, D, in(I_WINAB) + (size_t)i * D * NZ_E, NZ_E, Z, NZ_E, D);
            const float* hc = in(I_SCONV) + (size_t)i * NB_S * NHIST_C * DA; const float* hp = in(I_SPOOL) + (size_t)i * NB_S * NHIST_P * DB;
            k_even_mix<<<M, 512, 0, st>>>(Z, hc, hp, in(I_WDW) + (size_t)i * CONVW * DA, in(I_BDW) + (size_t)i * DA, in(I_GCLN) + (size_t)i * DA, in(I_BCLN) + (size_t)i * DA,
                                          in(I_WPOOL) + (size_t)i * 4 * 128 * 128, in(I_SPOOLS) + (size_t)i * DB, CAT);
            const size_t nst = (size_t)NB_P * NHIST_C * DA + (size_t)NB_P * NHIST_P * DB + (size_t)NB_S * NHIST_C * DA + (size_t)NB_S * NHIST_P * DB;
            k_states<<<(unsigned)((nst + 255) / 256), 256, 0, st>>>(Z, hc, hp, out, i);
            k_sgemm<<<dim3(D / 128, M / 128), 256, 0, st>>>(CAT, D, in(I_WOUTAB) + (size_t)i * D * D, D, OUT, D, D);
        } else {
            const int j = l >> 1;
            k_sgemm<<<dim3(NZ_O / 128, M / 128), 256, 0, st>>>(H, D, in(I_WINC) + (size_t)j * D * NZ_O, NZ_O, Z, NZ_O, D);
            k_vln<<<M, 256, 0, st>>>(Z, in(I_GV) + (size_t)j * D, in(I_BV) + (size_t)j * D, H, out, j);
            k_spatial<<<M, 256, 0, st>>>(Z, H, in(I_WSP) + (size_t)j * HC * CHUNK * CHUNK, in(I_BSP) + (size_t)j * HC * CHUNK, CAT);
            k_sgemm<<<dim3(D / 128, M / 128), 256, 0, st>>>(CAT, D, in(I_WOUTC) + (size_t)j * D * D, D, OUT, D, D);
        }
        k_resid<<<M, 256, 0, st>>>(X, OUT, D, mod_l, 2, 0);
        k_norm<<<M, 256, 0, st>>>(X, in(I_GFFN) + (size_t)l * D, mod_l, 3, 4, H);
        constexpr int RC = M / 4;
        for (int ch = 0; ch < 4; ++ch) {
            k_sgemm<<<dim3(FF / 128, RC / 128), 256, 0, st>>>(H + (size_t)ch * RC * D, D, in(I_WFFN1) + (size_t)l * D * FF, FF, HID, FF, D);
            k_relu2<<<(unsigned)(((size_t)RC * FF + 255) / 256), 256, 0, st>>>(HID, (size_t)RC * FF);
            k_sgemm<<<dim3(D / 128, RC / 128), 256, 0, st>>>(HID, FF, in(I_WFFN2) + (size_t)l * FF * D, D, OUT, D, FF);
            k_resid<<<RC, 256, 0, st>>>(X, OUT, D, mod_l, 5, ch * RC);
        }
    }
    k_norm<<<M, 256, 0, st>>>(X, in(I_GFINAL), nullptr, 0, 0, out + O_YP);
}
}

extern "C" void kernel_launch(void* const* d_in, const int* in_sizes, int n_in, void* d_out, int out_size, void* d_ws, size_t ws_size, hipStream_t stream) {
    if (n_in != N_INPUTS || (size_t)out_size != O_END || ws_size < (size_t)356 * (1 << 20)) {
        fprintf(stderr, "kernel_launch: unexpected shapes: n_in %d out %d ws %zu\n", n_in, out_size, ws_size); return; }
    naive::forward(d_in, (float*)d_out, (unsigned char*)d_ws, stream);
}
```

```cpp
#include <hip/hip_runtime.h>
#include <hip/hip_cooperative_groups.h>
#include <cstdio>
#include <cstdint>
namespace cg = cooperative_groups;

constexpr int D = 1024, NB_P = 8, T_P = 2048, NB_S = 128, T_S = 4, DEPTH = 4;
constexpr int MP = NB_P * T_P, MS = NB_S * T_S, M = MP + MS;
constexpr int NMODROWS = NB_P + NB_S;
constexpr int DA = 512, DB = 512, CONVW = 31, NHIST_C = 30, NHIST_P = 15, FF = 4096, NZ_E = 1536, NZ_O = 2048;
constexpr int HC = 8, DHC = 128, CHUNK = 128, PAST = 16384;
constexpr float EPS = 1e-6f;
constexpr int MODLD = DEPTH * 6 * D;

enum { I_XP = 0, I_XS, I_CP, I_CS, I_SCONV, I_SPOOL, I_WADA, I_BADA, I_GMIX, I_GFFN, I_WINAB, I_WDW, I_BDW, I_GCLN, I_BCLN,
       I_WPOOL, I_SPOOLS, I_WOUTAB, I_WINC, I_GV, I_BV, I_WSP, I_BSP, I_WOUTC, I_WFFN1, I_WFFN2, I_GFINAL, N_INPUTS };

constexpr size_t O_YP = 0, O_YS = O_YP + (size_t)MP * D, O_NCP = O_YS + (size_t)MS * D, O_NPP = O_NCP + (size_t)2 * NB_P * NHIST_C * DA,
                 O_NCS = O_NPP + (size_t)2 * NB_P * NHIST_P * DB, O_NPS = O_NCS + (size_t)2 * NB_S * NHIST_C * DA,
                 O_NV = O_NPS + (size_t)2 * NB_S * NHIST_P * DB, O_END = O_NV + (size_t)2 * NB_S * T_S * D;

__device__ __forceinline__ int modrow_of(int r) { return r < MP ? (r >> 11) : NB_P + ((r - MP) >> 2); }
namespace pg8 {
#define PG8_LAS __attribute__((address_space(3)))
typedef unsigned short bf16_t;
typedef short bf16x8 __attribute__((ext_vector_type(8)));
typedef float f32x4 __attribute__((ext_vector_type(4)));
typedef unsigned u32x4 __attribute__((ext_vector_type(4)));
constexpr int BM = 256, BK = 64, HALF = 128, HTB = HALF * BK * 2  , STAGE_BYTES = 8 * HTB, NXCD = 8, WGM = 8;

__host__ __device__ __forceinline__ int lds_byte(int r, int c) { const int st = (r >> 4) * 2 + (c >> 5), rr = r & 15, cc = c & 31, ob = rr * 64 + cc * 2; return st * 1024 + (ob ^ (((ob >> 9) & 1) << 5)); }
__host__ __device__ __forceinline__ void stage_rc(int b, int& R, int& C) { const int st = b / 1024, sb = b % 1024, swz = sb ^ (((sb >> 9) & 1) << 5); R = (st >> 1) * 16 + swz / 64; C = (st & 1) * 32 + (swz % 64) / 2; }
__host__ __device__ __forceinline__ int perm32(int rho) { const int n = rho >> 4, i = rho & 15; return 8 * (i >> 2) + 4 * n + (i & 3); }

struct Unit { int pm, pn; };
struct Gemm { const bf16_t* A; const bf16_t* Bt; int M, N, K; };

struct StaticOrder {
    int nM, nN, nwg, G, c;
    __host__ __device__ void init(int M, int N, int G_, int c_) { nM = M / BM; nN = N / BM; nwg = nM * nN; G = G_; c = c_; }
    __host__ __device__ bool next(int i, Unit& u) const {
        const long L = (long)i * G + c; if (L >= nwg) return false;
        int wgid = (int)L; { const int q = nwg / NXCD, r = nwg % NXCD, xcd = wgid % NXCD, off = wgid / NXCD; wgid = (xcd < r ? xcd * (q + 1) : r * (q + 1) + (xcd - r) * q) + off; }
        const int nig = WGM * nN, gid = wgid / nig, fm = gid * WGM, gsz = (nM - fm) < WGM ? (nM - fm) : WGM;
        u.pm = fm + ((wgid % nig) % gsz); u.pn = (wgid % nig) / gsz; return true;
    }
    __device__ __forceinline__ void a_ready(const Unit&) const {}
    __device__ __forceinline__ void done(const Unit&) const {}
};

__device__ __forceinline__ unsigned cvt_pk_bf16(float lo, float hi) { unsigned r; asm volatile("v_cvt_pk_bf16_f32 %0, %1, %2" : "=v"(r) : "v"(lo), "v"(hi)); return r; }
typedef float f32x2 __attribute__((ext_vector_type(2)));
__device__ __forceinline__ float sigmoid_fast(float v) { return __builtin_amdgcn_rcpf(1.0f + __expf(-v)); }
struct EpiGlu {
    static constexpr bool PERM = true, AFTER_DRAIN = false;
    bf16_t* Z;
    __device__ __forceinline__ void operator()(const f32x4 (&acc)[2][2][4][2], const Unit& u, int wr, int wc, int fr, int fq) const {
        const int row0 = u.pm * BM + wr * 64 + fr, cw = wc * 32 + 8 * fq;
        if (u.pn < 4) {
#pragma unroll
            for (int ai = 0; ai < 2; ++ai)
#pragma unroll
                for (int m = 0; m < 4; ++m) { bf16_t* rowp = Z + (size_t)(row0 + ai * HALF + m * 16) * D + 128 * u.pn + cw;
                    const f32x4 v0 = acc[ai][0][m][0], v1 = acc[ai][0][m][1], g0 = acc[ai][1][m][0], g1 = acc[ai][1][m][1]; float a[8];
#pragma unroll
                    for (int j = 0; j < 4; ++j) { a[j] = v0[j] * sigmoid_fast(g0[j]); a[4 + j] = v1[j] * sigmoid_fast(g1[j]); }
                    u32x4 w; w.x = cvt_pk_bf16(a[0], a[1]); w.y = cvt_pk_bf16(a[2], a[3]); w.z = cvt_pk_bf16(a[4], a[5]); w.w = cvt_pk_bf16(a[6], a[7]);
                    *(u32x4*)rowp = w; }
        } else {
#pragma unroll
            for (int ai = 0; ai < 2; ++ai)
#pragma unroll
                for (int m = 0; m < 4; ++m) { bf16_t* rowp = Z + (size_t)(row0 + ai * HALF + m * 16) * D + 512 + 256 * (u.pn - 4) + cw;
#pragma unroll
                    for (int bj = 0; bj < 2; ++bj) { const f32x4 v0 = acc[ai][bj][m][0], v1 = acc[ai][bj][m][1];
                        u32x4 w; w.x = cvt_pk_bf16(v0[0], v0[1]); w.y = cvt_pk_bf16(v0[2], v0[3]); w.z = cvt_pk_bf16(v1[0], v1[1]); w.w = cvt_pk_bf16(v1[2], v1[3]);
                        *(u32x4*)(rowp + bj * HALF) = w; } }
        }
    }
};
struct EpiUV {
    static constexpr bool PERM = true, AFTER_DRAIN = false;
    bf16_t* U; bf16_t* V; float* vstat;
    __device__ __forceinline__ void operator()(const f32x4 (&acc)[2][2][4][2], const Unit& u, int wr, int wc, int fr, int fq) const {
        const int row0 = u.pm * BM + wr * 64 + fr, cw = wc * 32 + 8 * fq; const bool isv = u.pn >= 4;
        bf16_t* base = (isv ? V + 256 * (u.pn - 4) : U + 256 * u.pn) + cw;
#pragma unroll
        for (int ai = 0; ai < 2; ++ai)
#pragma unroll
            for (int m = 0; m < 4; ++m) { const int row = row0 + ai * HALF + m * 16; bf16_t* rowp = base + (size_t)row * D; float s = 0.f, q = 0.f;
#pragma unroll
                for (int bj = 0; bj < 2; ++bj) { const f32x4 v0 = acc[ai][bj][m][0], v1 = acc[ai][bj][m][1];
                    u32x4 w; w.x = cvt_pk_bf16(v0[0], v0[1]); w.y = cvt_pk_bf16(v0[2], v0[3]); w.z = cvt_pk_bf16(v1[0], v1[1]); w.w = cvt_pk_bf16(v1[2], v1[3]);
                    *(u32x4*)(rowp + bj * HALF) = w;
                    s += (v0[0] + v0[1]) + (v0[2] + v0[3]) + (v1[0] + v1[1]) + (v1[2] + v1[3]);
                    q += (v0[0] * v0[0] + v0[1] * v0[1]) + (v0[2] * v0[2] + v0[3] * v0[3]) + (v1[0] * v1[0] + v1[1] * v1[1]) + (v1[2] * v1[2] + v1[3] * v1[3]); }
                if (isv) { s += __shfl_xor(s, 16); s += __shfl_xor(s, 32); q += __shfl_xor(q, 16); q += __shfl_xor(q, 32);
                    if (fq == 0) { f32x2 o; o.x = s; o.y = q; *(f32x2*)(vstat + ((size_t)row * 16 + (u.pn - 4) * 4 + wc) * 2) = o; } } }
    }
};
struct EpiRes {
    static constexpr bool PERM = false, AFTER_DRAIN = false;
    const float* xin_p; const float* xin_s; float* xout; const float* gate;
    __device__ __forceinline__ void operator()(const f32x4 (&acc)[2][2][4][2], const Unit& u, int wr, int wc, int fr, int fq) const {
        const int col0 = u.pn * BM + wc * 32 + 4 * fq;
#pragma unroll
        for (int ai = 0; ai < 2; ++ai)
#pragma unroll
            for (int m = 0; m < 4; ++m) { const int r = u.pm * BM + ai * HALF + wr * 64 + m * 16 + fr; const float* g = gate + (size_t)modrow_of(r) * MODLD + col0;
                const float* xi = (r < MP ? xin_p + (size_t)r * D : xin_s + (size_t)(r - MP) * D) + col0; float* xo = xout + (size_t)r * D + col0;
#pragma unroll
                for (int bj = 0; bj < 2; ++bj)
#pragma unroll
                    for (int n = 0; n < 2; ++n) { const int o = bj * HALF + n * 16; const f32x4 gv = *(const f32x4*)(g + o), xv = *(const f32x4*)(xi + o);
                        *(f32x4*)(xo + o) = xv + gv * acc[ai][bj][m][n]; } }
    }
};
struct EpiRelu2 {
    static constexpr bool PERM = true, AFTER_DRAIN = false;
    bf16_t* O;
    __device__ __forceinline__ void operator()(const f32x4 (&acc)[2][2][4][2], const Unit& u, int wr, int wc, int fr, int fq) const {
        const int row0 = u.pm * BM + wr * 64 + fr, col0 = u.pn * BM + wc * 32 + 8 * fq;
#pragma unroll
        for (int ai = 0; ai < 2; ++ai)
#pragma unroll
            for (int m = 0; m < 4; ++m) { bf16_t* rowp = O + (size_t)(row0 + ai * HALF + m * 16) * FF + col0;
#pragma unroll
                for (int bj = 0; bj < 2; ++bj) { f32x4 v0 = acc[ai][bj][m][0], v1 = acc[ai][bj][m][1];
#pragma unroll
                    for (int j = 0; j < 4; ++j) { const float a = fmaxf(v0[j], 0.f), b = fmaxf(v1[j], 0.f); v0[j] = a * a; v1[j] = b * b; }
                    u32x4 w; w.x = cvt_pk_bf16(v0[0], v0[1]); w.y = cvt_pk_bf16(v0[2], v0[3]); w.z = cvt_pk_bf16(v1[0], v1[1]); w.w = cvt_pk_bf16(v1[2], v1[3]);
                    *(u32x4*)(rowp + bj * HALF) = w; } }
    }
};
struct EpiMod {
    static constexpr bool PERM = false, AFTER_DRAIN = false;
    float* C; const float* bias;
    __device__ __forceinline__ void operator()(const f32x4 (&acc)[2][2][4][2], const Unit& u, int wr, int wc, int fr, int fq) const {
        const int col0 = u.pn * BM + wc * 32 + 4 * fq;
#pragma unroll
        for (int ai = 0; ai < 2; ++ai)
#pragma unroll
            for (int m = 0; m < 4; ++m) { const int r = ai * HALF + wr * 64 + m * 16 + fr;
                if (r < NMODROWS) { float* rowp = C + (size_t)r * MODLD + col0;
#pragma unroll
                    for (int bj = 0; bj < 2; ++bj)
#pragma unroll
                        for (int n = 0; n < 2; ++n) { const int o = bj * HALF + n * 16; *(f32x4*)(rowp + o) = acc[ai][bj][m][n] + *(const f32x4*)(bias + col0 + o); } } }
    }
};
template <class Epi, class Sched, bool ALIGN_EPI = false, bool SP2 = false>
__device__ __forceinline__ void gemm_phase(PG8_LAS unsigned char* lds, const Gemm g, const Sched& S, const Epi& E) {
    int tid_ = threadIdx.x; asm volatile("" : "+v"(tid_));
    const int tid = tid_, wid = __builtin_amdgcn_readfirstlane(tid >> 6), lane = tid & 63, wr = wid >> 2, wc = wid & 3, fr = lane & 15, fq = lane >> 4;
    const int K = g.K, nt = K / BK;
    unsigned voffA[2], voffB[2];
#pragma unroll
    for (int i = 0; i < 2; ++i) { int R, C; stage_rc(tid * 16 + i * 8192, R, C); const int Rb = Epi::PERM ? ((R & ~31) + perm32(R & 31)) : R;
        voffA[i] = (unsigned)(R * K + C) * 2u; voffB[i] = (unsigned)(Rb * K + C) * 2u; }
    const size_t kstep = (size_t)(BK * 2);
    const size_t hstep = (size_t)HALF * K * 2;
    const size_t tstep = 2 * hstep;
    const unsigned ldsw = (unsigned)wid * 1024u;
    const int aoff = lds_byte(wr * 64 + fr, fq * 8), boff = lds_byte(wc * 32 + fr, fq * 8);
#define PG8_SA(b, h) (((b) * 2 + (h)) * HTB)
#define PG8_SB(b, h) ((4 + (b) * 2 + (h)) * HTB)
#define PG8_STAGE(bufoff, gbase, voff) do { _Pragma("unroll") for (int _i = 0; _i < 2; ++_i) \
        __builtin_amdgcn_global_load_lds((const unsigned*)((const char*)(gbase) + (voff)[_i]), (PG8_LAS unsigned*)(lds + (bufoff) + ldsw + _i * 8192), 16, 0, 0); } while (0)
#define PG8_LDA(dst, b, h) do { _Pragma("unroll") for (int m = 0; m < 4; ++m) _Pragma("unroll") for (int k = 0; k < 2; ++k) dst[m][k] = *(const PG8_LAS bf16x8*)(lds + PG8_SA(b, h) + aoff + m * 2048 + k * 1024); } while (0)
#define PG8_LDB(dst, b, h) do { _Pragma("unroll") for (int n = 0; n < 2; ++n) _Pragma("unroll") for (int k = 0; k < 2; ++k) dst[n][k] = *(const PG8_LAS bf16x8*)(lds + PG8_SB(b, h) + boff + n * 2048 + k * 1024); } while (0)
#define PG8_MMA(ai, bj, At, Bt) do { __builtin_amdgcn_s_setprio(1); _Pragma("unroll") for (int m = 0; m < 4; ++m) _Pragma("unroll") for (int n = 0; n < 2; ++n) _Pragma("unroll") for (int k = 0; k < 2; ++k) \
        acc[ai][bj][m][n] = __builtin_amdgcn_mfma_f32_16x16x32_bf16(Bt[n][k], At[m][k], acc[ai][bj][m][n], 0, 0, 0); __builtin_amdgcn_s_setprio(0); } while (0)
#define PG8_WAIT_V(n) asm volatile("s_waitcnt vmcnt(" #n ")" ::: "memory")
#define PG8_WAIT_L(n) asm volatile("s_waitcnt lgkmcnt(" #n ")" ::: "memory")
#define PG8_BAR __builtin_amdgcn_s_barrier()
#define PG8_SCHED __builtin_amdgcn_sched_barrier(0)
    Unit cur, nxt; int ui = 0;
    if (!S.next(0, cur)) return;
    f32x4 acc[2][2][4][2];
#pragma unroll
    for (int a = 0; a < 2; ++a)
#pragma unroll
        for (int b = 0; b < 2; ++b)
#pragma unroll
            for (int m = 0; m < 4; ++m)
#pragma unroll
                for (int n = 0; n < 2; ++n) acc[a][b][m][n] = (f32x4){0.f, 0.f, 0.f, 0.f};
    bf16x8 At[4][2], B0[2][2], B1[2][2];
    const char* cA = (const char*)g.A + (size_t)cur.pm * tstep; const char* cB = (const char*)g.Bt + (size_t)cur.pn * tstep;
    S.a_ready(cur);
    if constexpr (SP2) {
        PG8_STAGE(PG8_SB(0, 0), cB, voffB); PG8_STAGE(PG8_SB(0, 1), cB + hstep, voffB); PG8_STAGE(PG8_SA(0, 0), cA, voffA); PG8_STAGE(PG8_SA(0, 1), cA + hstep, voffA);
        if (wr == 1) PG8_BAR;
        PG8_WAIT_V(2); PG8_BAR;
        PG8_STAGE(PG8_SB(1, 0), cB + kstep, voffB); PG8_STAGE(PG8_SA(1, 0), cA + kstep, voffA); PG8_STAGE(PG8_SB(1, 1), cB + hstep + kstep, voffB);
        PG8_WAIT_V(6); PG8_BAR;
    } else {
        PG8_STAGE(PG8_SB(0, 0), cB, voffB); PG8_STAGE(PG8_SA(0, 0), cA, voffA); PG8_STAGE(PG8_SB(0, 1), cB + hstep, voffB); PG8_STAGE(PG8_SA(0, 1), cA + hstep, voffA);
        if (wr == 1) PG8_BAR;
        PG8_WAIT_V(4); PG8_BAR;
        PG8_STAGE(PG8_SB(1, 0), cB + kstep, voffB); PG8_STAGE(PG8_SA(1, 0), cA + kstep, voffA); PG8_STAGE(PG8_SB(1, 1), cB + hstep + kstep, voffB);
        PG8_WAIT_V(6); PG8_BAR;
    }
    for (;;) {
        const bool has_next = S.next(ui + 1, nxt);
        const char* nA = has_next ? (const char*)g.A + (size_t)nxt.pm * tstep : cA; const char* nB = has_next ? (const char*)g.Bt + (size_t)nxt.pn * tstep : cB;
        for (int t = 0; t < nt; t += 2) {
            const bool last = (t == nt - 2);
            const char* a1 = cA + (size_t)(t + 1) * kstep;
            const char* a2 = last ? nA : cA + (size_t)(t + 2) * kstep; const char* b2 = last ? nB : cB + (size_t)(t + 2) * kstep;
            const char* a3 = a2 + kstep; const char* b3 = b2 + kstep;
            if (last && has_next) S.a_ready(nxt);
            if constexpr (SP2) {
            PG8_LDB(B0, 0, 0); PG8_LDB(B1, 0, 1); PG8_SCHED; PG8_LDA(At, 0, 0); PG8_STAGE(PG8_SA(1, 1), a1 + hstep, voffA);
            PG8_WAIT_V(8); PG8_WAIT_L(0); PG8_BAR; PG8_MMA(0, 0, At, B0); PG8_MMA(0, 1, At, B1); PG8_BAR; PG8_SCHED;
            PG8_LDA(At, 0, 1); PG8_STAGE(PG8_SB(0, 0), b2, voffB); PG8_STAGE(PG8_SB(0, 1), b2 + hstep, voffB); PG8_STAGE(PG8_SA(0, 0), a2, voffA);
            PG8_WAIT_V(8); PG8_WAIT_L(0); PG8_BAR; PG8_MMA(1, 0, At, B0); PG8_MMA(1, 1, At, B1); PG8_BAR; PG8_SCHED;
            PG8_LDB(B0, 1, 0); PG8_LDB(B1, 1, 1); PG8_SCHED; PG8_LDA(At, 1, 0); PG8_STAGE(PG8_SA(0, 1), a2 + hstep, voffA);
            PG8_WAIT_V(8); PG8_WAIT_L(0); PG8_BAR; PG8_MMA(0, 0, At, B0); PG8_MMA(0, 1, At, B1); PG8_BAR; PG8_SCHED;
            PG8_LDA(At, 1, 1); PG8_STAGE(PG8_SB(1, 0), b3, voffB); PG8_STAGE(PG8_SB(1, 1), b3 + hstep, voffB); PG8_STAGE(PG8_SA(1, 0), a3, voffA);
            PG8_WAIT_V(8); PG8_WAIT_L(0); PG8_BAR; PG8_MMA(1, 0, At, B0); PG8_MMA(1, 1, At, B1); PG8_BAR; PG8_SCHED;
            } else {
            PG8_LDB(B0, 0, 0); PG8_SCHED; PG8_LDA(At, 0, 0); PG8_STAGE(PG8_SA(1, 1), a1 + hstep, voffA);
            PG8_WAIT_L(8); PG8_BAR; PG8_WAIT_L(0); PG8_MMA(0, 0, At, B0); PG8_BAR; PG8_SCHED;
            PG8_LDB(B1, 0, 1); PG8_STAGE(PG8_SB(0, 0), b2, voffB);
            PG8_BAR; PG8_WAIT_L(0); PG8_MMA(0, 1, At, B1); PG8_BAR;
            PG8_LDA(At, 0, 1); PG8_STAGE(PG8_SA(0, 0), a2, voffA);
            PG8_BAR; PG8_WAIT_L(0); PG8_MMA(1, 0, At, B0); PG8_BAR; PG8_SCHED;
            PG8_STAGE(PG8_SB(0, 1), b2 + hstep, voffB);
            PG8_WAIT_V(6); PG8_BAR; PG8_MMA(1, 1, At, B1); PG8_BAR;
            PG8_LDB(B0, 1, 0); PG8_SCHED; PG8_LDA(At, 1, 0); PG8_STAGE(PG8_SA(0, 1), a2 + hstep, voffA);
            PG8_WAIT_L(8); PG8_BAR; PG8_WAIT_L(0); PG8_MMA(0, 0, At, B0); PG8_BAR; PG8_SCHED;
            PG8_LDB(B1, 1, 1); PG8_STAGE(PG8_SB(1, 0), b3, voffB);
            PG8_BAR; PG8_WAIT_L(0); PG8_MMA(0, 1, At, B1); PG8_BAR;
            PG8_LDA(At, 1, 1); PG8_STAGE(PG8_SA(1, 0), a3, voffA);
            PG8_BAR; PG8_WAIT_L(0); PG8_MMA(1, 0, At, B0); PG8_BAR; PG8_SCHED;
            PG8_STAGE(PG8_SB(1, 1), b3 + hstep, voffB);
            PG8_WAIT_V(6); PG8_BAR; PG8_MMA(1, 1, At, B1); PG8_BAR;
            }
        }
        if constexpr (ALIGN_EPI) { if (wr == 0) PG8_BAR; }
        if constexpr (!Epi::AFTER_DRAIN) { E(acc, cur, wr, wc, fr, fq); S.done(cur); }
        if (!has_next) break;
#pragma unroll
        for (int a = 0; a < 2; ++a)
#pragma unroll
            for (int b = 0; b < 2; ++b)
#pragma unroll
                for (int m = 0; m < 4; ++m)
#pragma unroll
                    for (int n = 0; n < 2; ++n) acc[a][b][m][n] = (f32x4){0.f, 0.f, 0.f, 0.f};
        cur = nxt; cA = nA; cB = nB; ++ui;
        if constexpr (ALIGN_EPI) { if (wr == 1) PG8_BAR; }
    }
    PG8_WAIT_V(0);
    if constexpr (!ALIGN_EPI) { if (wr == 0) PG8_BAR; }
    PG8_BAR;
    if constexpr (Epi::AFTER_DRAIN) { E.fused(acc, cur, wr, wc, fr, fq, lds, wid, lane); S.done(cur); }
#undef PG8_SA
#undef PG8_SB
#undef PG8_STAGE
#undef PG8_LDA
#undef PG8_LDB
#undef PG8_MMA
#undef PG8_WAIT_V
#undef PG8_WAIT_L
#undef PG8_BAR
#undef PG8_SCHED
}
}
#define GAS __attribute__((address_space(1)))
#define LAS __attribute__((address_space(3)))
typedef unsigned short bf16;
typedef unsigned v4u __attribute__((ext_vector_type(4)));
typedef unsigned v2u __attribute__((ext_vector_type(2)));
typedef float f32x4 __attribute__((ext_vector_type(4)));
typedef float f32x2 __attribute__((ext_vector_type(2)));
typedef short bf16x8 __attribute__((ext_vector_type(8)));
typedef short s16x4 __attribute__((ext_vector_type(4)));
#define LDS_WAIT() asm volatile("s_waitcnt lgkmcnt(0)" ::: "memory")
#define VM_WAIT() asm volatile("s_waitcnt vmcnt(0)" ::: "memory")
__device__ __forceinline__ unsigned f2bf(float f) { unsigned u = __builtin_bit_cast(unsigned, f); return (u + 0x7fffu + ((u >> 16) & 1u)) >> 16; }
__device__ __forceinline__ unsigned pk2(float lo, float hi) { return f2bf(lo) | (f2bf(hi) << 16); }
__device__ __forceinline__ float bflo(unsigned w) { return __builtin_bit_cast(float, w << 16); }
__device__ __forceinline__ float bfhi(unsigned w) { return __builtin_bit_cast(float, w & 0xffff0000u); }
__device__ __forceinline__ float bf1(bf16 h) { return __builtin_bit_cast(float, (unsigned)h << 16); }
__device__ __forceinline__ float wave_sum(float v) {
#pragma unroll
    for (int o = 1; o < 64; o <<= 1) v += __shfl_xor(v, o);
    return v;
}
__device__ __forceinline__ float silu_f(float v) { return v / (1.0f + __expf(-v)); }

constexpr size_t MiB = 1u << 20;
constexpr size_t WS_CTL = 0;
constexpr size_t WS_WINE = 1 * MiB;
constexpr size_t WS_WOUTE = 7 * MiB;
constexpr size_t WS_WINO = 11 * MiB;
constexpr size_t WS_WOUTO = 19 * MiB;
constexpr size_t WS_W1 = 23 * MiB;
constexpr size_t WS_W2 = 55 * MiB;
constexpr size_t WS_WPOOL = 87 * MiB;
constexpr size_t WS_WSP = 87 * MiB + 512 * 1024;
constexpr size_t WS_CSILU = 88 * MiB;
constexpr size_t WS_VSTAT = 89 * MiB;
constexpr size_t WS_MODG = 92 * MiB;
constexpr size_t WS_X = 105 * MiB;
constexpr size_t WS_H = 171 * MiB;
constexpr size_t WS_R = 204 * MiB;
constexpr size_t WS_Z0 = WS_R, WS_Z1 = WS_R + 33 * MiB, WS_CAT = WS_R + 66 * MiB, WS_WADA = WS_R, WS_HID = WS_R;
constexpr size_t WS_END = WS_R + 132 * MiB;
static_assert((size_t)M * D * 2 <= 33 * MiB && (size_t)M * FF * 2 <= 132 * MiB && (size_t)NMODROWS * MODLD * 4 <= 13 * MiB && (size_t)M * 32 * 4 <= 3 * MiB, "ws map");

constexpr int NWAVES = 8, NTHREADS = 512;
constexpr int LDS_BYTES = 147456;

struct Args { const float* in[N_INPUTS]; float* out; unsigned char* ws; };
__device__ __forceinline__ int permE(int n0) {
    if (n0 < 512) return (n0 >> 7) * 256 + (n0 & 127);
    if (n0 < 1024) return ((n0 - 512) >> 7) * 256 + 128 + ((n0 - 512) & 127);
    return n0;
}
__device__ __forceinline__ void tr_item(const float* W, int K, int N, bf16* WT, bool perm, LAS float* scr, int item, int lane) {
    const int nblk = N >> 5, kb = item / nblk, nb = item - kb * nblk, k0 = 64 * kb, n0 = 32 * nb, d0 = perm ? permE(n0) : n0;
#pragma unroll 8
    for (int i = 0; i < 32; ++i) { const int kk = 2 * i + (lane >> 5); scr[kk * 33 + (lane & 31)] = W[(size_t)(k0 + kk) * N + n0 + (lane & 31)]; }
    LDS_WAIT(); asm volatile("" ::: "memory");
    const int c = lane & 7;
#pragma unroll
    for (int j = 0; j < 4; ++j) { const int n = (lane >> 3) + 8 * j; const LAS float* s = scr + (8 * c) * 33 + n;
        v4u o; o.x = pk2(s[0 * 33], s[1 * 33]); o.y = pk2(s[2 * 33], s[3 * 33]); o.z = pk2(s[4 * 33], s[5 * 33]); o.w = pk2(s[6 * 33], s[7 * 33]);
        *(v4u*)(WT + (size_t)(d0 + n) * K + k0 + 8 * c) = o; }
    LDS_WAIT(); asm volatile("" ::: "memory");
}
__device__ __forceinline__ void prologue_phase(const Args& a, LAS unsigned char* lds, int bid, int G) {
    int tid = threadIdx.x; asm volatile("" : "+v"(tid)); const int lane = tid & 63, wave = __builtin_amdgcn_readfirstlane(tid >> 6), gw = bid * NWAVES + wave, NGW = G * NWAVES;
    unsigned char* ws = a.ws;
    LAS float* scr = (LAS float*)(lds + wave * 16384);
    constexpr int C_ADA = 16 * 192, C_INE = 16 * 48, C_SQ = 16 * 32, C_INO = 16 * 64, C_F1 = 16 * 128, C_F2 = 64 * 32, C_PL = 2 * 4;
    constexpr int NITEMS = 4 * C_ADA + 2 * C_INE + 2 * C_SQ + 2 * C_INO + 2 * C_SQ + 4 * C_F1 + 4 * C_F2 + 8 * C_PL;
    for (int it = gw; it < NITEMS; it += NGW) {
        int r = it;
        if (r < 4 * C_ADA) { const int l = r / C_ADA; tr_item(a.in[I_WADA] + (size_t)l * D * 6 * D, D, 6 * D, (bf16*)(ws + WS_WADA) + (size_t)l * 6 * D * D, false, scr, r - l * C_ADA, lane); continue; } r -= 4 * C_ADA;
        if (r < 2 * C_INE) { const int l = r / C_INE; tr_item(a.in[I_WINAB] + (size_t)l * D * NZ_E, D, NZ_E, (bf16*)(ws + WS_WINE) + (size_t)l * NZ_E * D, true, scr, r - l * C_INE, lane); continue; } r -= 2 * C_INE;
        if (r < 2 * C_SQ) { const int l = r / C_SQ; tr_item(a.in[I_WOUTAB] + (size_t)l * D * D, D, D, (bf16*)(ws + WS_WOUTE) + (size_t)l * D * D, false, scr, r - l * C_SQ, lane); continue; } r -= 2 * C_SQ;
        if (r < 2 * C_INO) { const int l = r / C_INO; tr_item(a.in[I_WINC] + (size_t)l * D * NZ_O, D, NZ_O, (bf16*)(ws + WS_WINO) + (size_t)l * NZ_O * D, false, scr, r - l * C_INO, lane); continue; } r -= 2 * C_INO;
        if (r < 2 * C_SQ) { const int l = r / C_SQ; tr_item(a.in[I_WOUTC] + (size_t)l * D * D, D, D, (bf16*)(ws + WS_WOUTO) + (size_t)l * D * D, false, scr, r - l * C_SQ, lane); continue; } r -= 2 * C_SQ;
        if (r < 4 * C_F1) { const int l = r / C_F1; tr_item(a.in[I_WFFN1] + (size_t)l * D * FF, D, FF, (bf16*)(ws + WS_W1) + (size_t)l * FF * D, false, scr, r - l * C_F1, lane); continue; } r -= 4 * C_F1;
        if (r < 4 * C_F2) { const int l = r / C_F2; tr_item(a.in[I_WFFN2] + (size_t)l * FF * D, FF, D, (bf16*)(ws + WS_W2) + (size_t)l * D * FF, false, scr, r - l * C_F2, lane); continue; } r -= 4 * C_F2;
        { const int l = r / C_PL; tr_item(a.in[I_WPOOL] + (size_t)l * 128 * 128, 128, 128, (bf16*)(ws + WS_WPOOL) + (size_t)l * 128 * 128, false, scr, r - l * C_PL, lane); }
    }
    const int gt = gw * 64 + lane, NGT = NGW * 64;
    for (int i = gt; i < 256 * D / 4; i += NGT) { const int r = i >> 8, k = (i & 255) * 4; v2u o; o.x = 0u; o.y = 0u;
        if (r < NMODROWS) { const float* c = (r < NB_P ? a.in[I_CP] + (size_t)r * D : a.in[I_CS] + (size_t)(r - NB_P) * D) + k; const f32x4 v = *(const f32x4*)c;
            o.x = pk2(silu_f(v.x), silu_f(v.y)); o.y = pk2(silu_f(v.z), silu_f(v.w)); }
        *(v2u*)((bf16*)(ws + WS_CSILU) + (size_t)r * D + k) = o; }
    for (int i = gt; i < 2 * HC * CHUNK * CHUNK / 4; i += NGT) { const int e = i * 4, s = e & 127, t = (e >> 7) & 127; const f32x4 v = *(const f32x4*)(a.in[I_WSP] + e);
        v2u o; o.x = pk2(s <= t ? v.x : 0.f, s + 1 <= t ? v.y : 0.f); o.y = pk2(s + 2 <= t ? v.z : 0.f, s + 3 <= t ? v.w : 0.f);
        *(v2u*)((bf16*)(ws + WS_WSP) + e) = o; }
}
template <bool FINAL>
__device__ __forceinline__ void norm_phase(const float* xp, const float* xs, const float* g, const float* modl, int i_shift, int i_scale, bf16* H, float* out, int bid, int G) {
    int tid = threadIdx.x; asm volatile("" : "+v"(tid)); const int lane = tid & 63, wave = __builtin_amdgcn_readfirstlane(tid >> 6), gw = bid * NWAVES + wave, NGW = G * NWAVES;
    for (int r = gw; r < M; r += NGW) {
        const float* x = (r < MP ? xp + (size_t)r * D : xs + (size_t)(r - MP) * D) + 4 * lane;
        f32x4 v[4]; float ss = 0.f;
#pragma unroll
        for (int j = 0; j < 4; ++j) { v[j] = *(const f32x4*)(x + 256 * j); ss += (v[j].x * v[j].x + v[j].y * v[j].y) + (v[j].z * v[j].z + v[j].w * v[j].w); }
        const float rstd = rsqrtf(wave_sum(ss) * (1.0f / D) + EPS);
        if (FINAL) {
#pragma unroll
            for (int j = 0; j < 4; ++j) { const int k = 4 * lane + 256 * j; const f32x4 gg = *(const f32x4*)(g + k); *(f32x4*)(out + (size_t)r * D + k) = v[j] * rstd * gg; }
        } else {
            const float* mrow = modl + (size_t)modrow_of(r) * MODLD;
#pragma unroll
            for (int j = 0; j < 4; ++j) { const int k = 4 * lane + 256 * j; const f32x4 gg = *(const f32x4*)(g + k), sc = *(const f32x4*)(mrow + i_scale * D + k), sh = *(const f32x4*)(mrow + i_shift * D + k);
                const f32x4 y = v[j] * rstd * gg * (sc + 1.0f) + sh; v2u o; o.x = pk2(y.x, y.y); o.y = pk2(y.z, y.w); *(v2u*)(H + (size_t)r * D + k) = o; }
        }
    }
}
__device__ __forceinline__ v4u pack8(const f32x4 a, const f32x4 b) { v4u w; w.x = pk2(a.x, a.y); w.y = pk2(a.z, a.w); w.z = pk2(b.x, b.y); w.w = pk2(b.z, b.w); return w; }

constexpr int MX_DOFF = 49152, MX_DROW = 1040, MX_RED = 86016, MX_STAT = 88064;
__device__ __forceinline__ void mix_even_phase(LAS unsigned char* lds, int i, const bf16* Z, bf16* CAT, const float* sconv, const float* spool, const float* w_dw, const float* b_dw,
                                               const float* g_cln, const float* b_cln, const bf16* wpool_t, const float* s_pool, float* out, int bid, int G) {
    int tid = threadIdx.x; asm volatile("" : "+v"(tid)); const int lane = tid & 63, wave = __builtin_amdgcn_readfirstlane(tid >> 6);
    for (int it = bid; it < 640; it += G) {
        int b, t0, ntok, s0; bool samp;
        if (it < 512) { b = it >> 6; t0 = (it & 63) << 5; ntok = 32; s0 = b * T_P; samp = false; }
        else { b = it - 512; t0 = 0; ntok = T_S; s0 = MP + b * T_S; samp = true; }
        const bool last = (!samp) && (t0 == T_P - 32);
        { const int ch = tid & 63;
          for (int e = tid >> 6; e < NHIST_P + ntok; e += 8) { const int tt = t0 - NHIST_P + e; v4u w = (v4u){0u, 0u, 0u, 0u};
              if (tt >= 0) w = *(const v4u*)(Z + (size_t)(s0 + tt) * D + 512 + 8 * ch);
              else if (samp) { const float* hp = spool + ((size_t)b * NHIST_P + (NHIST_P + tt)) * DB + 8 * ch; w = pack8(*(const f32x4*)hp, *(const f32x4*)(hp + 4)); }
              *(LAS v4u*)(lds + e * 1024 + 16 * ch) = w; } }
        __syncthreads();
        { const int c = tid, g = c >> 7, w = 2 << g; const LAS bf16* P = (const LAS bf16*)lds; LAS bf16* Ds = (LAS bf16*)(lds + MX_DOFF);
          for (int t = 0; t < 32; ++t) { float s = 0.f;
              for (int k = 0; k < w; ++k) s += bf1(P[(NHIST_P + t - k) * 512 + c]);
              const int pos = (samp ? PAST : 0) + t0 + t + 1; const float cnt = (float)(w < pos ? w : pos);
              Ds[t * (MX_DROW / 2) + c] = (bf16)f2bf(s / cnt - bf1(P[(NHIST_P + t) * 512 + c])); }
          if (last) { for (int t = 17; t < 32; ++t) out[O_NPP + (((size_t)i * NB_P + b) * NHIST_P + (t - 17)) * DB + c] = bf1(P[(NHIST_P + t) * 512 + c]); }
          if (samp) { for (int j = 0; j < NHIST_P; ++j) out[O_NPS + (((size_t)i * NB_S + b) * NHIST_P + j) * DB + c] = j < 11 ? spool[((size_t)b * NHIST_P + j + 4) * DB + c] : bf1(P[(NHIST_P + j - 11) * 512 + c]); } }
        __syncthreads();
        { const int g = wave >> 1, fr = lane & 15, fq = lane >> 4; f32x4 acc[2][4];
#pragma unroll
          for (int mi = 0; mi < 2; ++mi)
#pragma unroll
              for (int ni = 0; ni < 4; ++ni) acc[mi][ni] = (f32x4){0.f, 0.f, 0.f, 0.f};
          const bf16* wp = wpool_t + ((size_t)g * 128 + 64 * (wave & 1)) * 128;
#pragma unroll
          for (int kk = 0; kk < 4; ++kk) { bf16x8 bfr[2], afr[4];
#pragma unroll
              for (int mi = 0; mi < 2; ++mi) bfr[mi] = *(const LAS bf16x8*)(lds + MX_DOFF + (16 * mi + fr) * MX_DROW + (g * 128 + 32 * kk + 8 * fq) * 2);
#pragma unroll
              for (int ni = 0; ni < 4; ++ni) afr[ni] = *(const bf16x8*)(wp + (size_t)(16 * ni + fr) * 128 + 32 * kk + 8 * fq);
#pragma unroll
              for (int mi = 0; mi < 2; ++mi)
#pragma unroll
                  for (int ni = 0; ni < 4; ++ni) acc[mi][ni] = __builtin_amdgcn_mfma_f32_16x16x32_bf16(afr[ni], bfr[mi], acc[mi][ni], 0, 0, 0); }
#pragma unroll
          for (int mi = 0; mi < 2; ++mi) { const int t = 16 * mi + fr;
              if (t < ntok) {
#pragma unroll
                  for (int ni = 0; ni < 4; ++ni) { const int col = 64 * wave + 16 * ni + 4 * fq; const f32x4 sp = *(const f32x4*)(s_pool + col), y = acc[mi][ni] * sp;
                      v2u o; o.x = pk2(y.x, y.y); o.y = pk2(y.z, y.w); *(v2u*)(CAT + (size_t)(s0 + t0 + t) * D + 512 + col) = o; } } } }
        __syncthreads();
        { const int ch = tid & 63;
          for (int e = tid >> 6; e < NHIST_C + ntok; e += 8) { const int tt = t0 - NHIST_C + e; v4u w = (v4u){0u, 0u, 0u, 0u};
              if (tt >= 0) w = *(const v4u*)(Z + (size_t)(s0 + tt) * D + 8 * ch);
              else if (samp) { const float* hp = sconv + ((size_t)b * NHIST_C + (NHIST_C + tt)) * DA + 8 * ch; w = pack8(*(const f32x4*)hp, *(const f32x4*)(hp + 4)); }
              *(LAS v4u*)(lds + e * 1024 + 16 * ch) = w; } }
        __syncthreads();
        { const int c = tid; const LAS bf16* A = (const LAS bf16*)lds; LAS float* RED = (LAS float*)(lds + MX_RED); LAS float* STAT = (LAS float*)(lds + MX_STAT);
          float wv[CONVW], av[62], cv[32];
#pragma unroll
          for (int j = 0; j < CONVW; ++j) wv[j] = w_dw[j * DA + c];
#pragma unroll
          for (int e = 0; e < 62; ++e) av[e] = bf1(A[e * 512 + c]);
          const float bias = b_dw[c];
#pragma unroll
          for (int t = 0; t < 32; ++t) { float acc = bias;
#pragma unroll
              for (int j = 0; j < CONVW; ++j) acc += wv[j] * av[t + j];
              cv[t] = acc; }
#pragma unroll
          for (int t = 0; t < 32; ++t) { const float s = wave_sum(cv[t]), q = wave_sum(cv[t] * cv[t]); if (lane == 0) { RED[(wave * 32 + t) * 2] = s; RED[(wave * 32 + t) * 2 + 1] = q; } }
          __syncthreads();
          if (tid < 32) { float s = 0.f, q = 0.f;
#pragma unroll
              for (int w = 0; w < 8; ++w) { s += RED[(w * 32 + tid) * 2]; q += RED[(w * 32 + tid) * 2 + 1]; }
              const float mean = s * (1.0f / DA), var = fmaxf(q * (1.0f / DA) - mean * mean, 0.f); STAT[tid * 2] = mean; STAT[tid * 2 + 1] = rsqrtf(var + EPS); }
          __syncthreads();
          const float gc = g_cln[c], bc = b_cln[c];
#pragma unroll
          for (int t = 0; t < 32; ++t) if (t < ntok) { const float y = (cv[t] - STAT[t * 2]) * STAT[t * 2 + 1] * gc + bc; CAT[(size_t)(s0 + t0 + t) * D + c] = (bf16)f2bf(silu_f(y)); }
          if (last) {
#pragma unroll
              for (int t = 2; t < 32; ++t) out[O_NCP + (((size_t)i * NB_P + b) * NHIST_C + (t - 2)) * DA + c] = av[30 + t]; }
          if (samp) {
#pragma unroll
              for (int j = 0; j < NHIST_C; ++j) out[O_NCS + (((size_t)i * NB_S + b) * NHIST_C + j) * DA + c] = j < 26 ? sconv[((size_t)b * NHIST_C + j + 4) * DA + c] : av[30 + (j - 26)]; } }
        __syncthreads();
    }
}

__device__ __forceinline__ unsigned off_b(unsigned row, unsigned ch) { return 256u * row + 16u * (ch ^ (((row & 3) << 2) | ((row >> 2) & 3))); }
__device__ __forceinline__ unsigned tr_addr16(unsigned lane, unsigned c, unsigned ks, unsigned t) { const unsigned g = lane >> 4, q = (lane & 15) >> 2, p = lane & 3; return off_b(32 * ks + 8 * g + 4 * t + q, 2 * c + (p >> 1)) + 8 * (p & 1); }
__device__ __forceinline__ s16x4 tr_read(LAS unsigned char* p) { return __builtin_bit_cast(s16x4, __builtin_amdgcn_ds_read_tr16_b64_v4i16((LAS s16x4*)p)); }
__device__ __forceinline__ void mix_odd_phase(LAS unsigned char* lds, int j, const bf16* U, const bf16* V, const float* vstat, bf16* Y, const float* g_v, const float* b_v, const bf16* wsbf,
                                              const float* w_sp, const float* b_sp, float* out, int bid, int G) {
    int tid = threadIdx.x; asm volatile("" : "+v"(tid)); const int lane = tid & 63, wave = __builtin_amdgcn_readfirstlane(tid >> 6);
    for (int it = bid; it < 1024 + NB_S; it += G) {
        if (it < 1024) {
            const int ck = it >> 3, h = it & 7, row0 = ck * CHUNK;
            { const int s = tid >> 2, q = tid & 3, row = row0 + s; const f32x4* sp = (const f32x4*)(vstat + (size_t)row * 32); float S = 0.f, Q = 0.f;
#pragma unroll
              for (int k = 0; k < 8; ++k) { const f32x4 v = sp[k]; S += v.x + v.z; Q += v.y + v.w; }
              const float mean = S * (1.0f / D), rstd = rsqrtf(fmaxf(Q * (1.0f / D) - mean * mean, 0.f) + EPS);
#pragma unroll
              for (int cc = 0; cc < 4; ++cc) { const int ch = 4 * q + cc, c0 = 128 * h + 8 * ch; const v4u w = *(const v4u*)(V + (size_t)row * D + c0);
                  const f32x4 g0 = *(const f32x4*)(g_v + c0), g1 = *(const f32x4*)(g_v + c0 + 4), b0 = *(const f32x4*)(b_v + c0), b1 = *(const f32x4*)(b_v + c0 + 4);
                  f32x4 x0 = (f32x4){bflo(w.x), bfhi(w.x), bflo(w.y), bfhi(w.y)}, x1 = (f32x4){bflo(w.z), bfhi(w.z), bflo(w.w), bfhi(w.w)};
                  x0 = (x0 - mean) * rstd * g0 + b0; x1 = (x1 - mean) * rstd * g1 + b1;
                  *(LAS v4u*)(lds + off_b(s, ch)) = pack8(x0, x1); } }
            __syncthreads();
            { const int fr = lane & 15, fq = lane >> 4, t = 16 * wave + fr, nks = (wave >> 1) + 1; f32x4 acc[8];
#pragma unroll
              for (int cb = 0; cb < 8; ++cb) acc[cb] = (f32x4){0.f, 0.f, 0.f, 0.f};
              const bf16* wsrow = wsbf + ((size_t)h * CHUNK + t) * CHUNK;
              for (int ks = 0; ks < nks; ++ks) { const bf16x8 bfr = *(const bf16x8*)(wsrow + 32 * ks + 8 * fq);
#pragma unroll
                  for (int cb = 0; cb < 8; ++cb) { const s16x4 lo = tr_read(lds + tr_addr16(lane, cb, ks, 0)), hi = tr_read(lds + tr_addr16(lane, cb, ks, 1));
                      const bf16x8 afr = (bf16x8){lo[0], lo[1], lo[2], lo[3], hi[0], hi[1], hi[2], hi[3]};
                      acc[cb] = __builtin_amdgcn_mfma_f32_16x16x32_bf16(afr, bfr, acc[cb], 0, 0, 0); } }
              const float bs = b_sp[h * CHUNK + t];
#pragma unroll
              for (int cb = 0; cb < 8; ++cb) { const size_t o = (size_t)(row0 + t) * D + 128 * h + 16 * cb + 4 * fq; const v2u uu = *(const v2u*)(U + o);
                  v2u y; y.x = pk2(bflo(uu.x) * (acc[cb].x + bs), bfhi(uu.x) * (acc[cb].y + bs)); y.y = pk2(bflo(uu.y) * (acc[cb].z + bs), bfhi(uu.y) * (acc[cb].w + bs)); *(v2u*)(Y + o) = y; } }
            __syncthreads();
        } else {
            const int b = it - 1024, r0 = MP + T_S * b; LAS float* ST = (LAS float*)(lds + 32768);
            if (tid < T_S) { const f32x4* sp = (const f32x4*)(vstat + (size_t)(r0 + tid) * 32); float S = 0.f, Q = 0.f;
#pragma unroll
                for (int k = 0; k < 8; ++k) { const f32x4 v = sp[k]; S += v.x + v.z; Q += v.y + v.w; }
                const float mean = S * (1.0f / D); ST[2 * tid] = mean; ST[2 * tid + 1] = rsqrtf(fmaxf(Q * (1.0f / D) - mean * mean, 0.f) + EPS); }
            __syncthreads();
            { const int c = 2 * tid, h = c >> 7; const f32x2 gg = *(const f32x2*)(g_v + c), bb = *(const f32x2*)(b_v + c); float vn[T_S][2];
#pragma unroll
              for (int s = 0; s < T_S; ++s) { const unsigned w = *(const unsigned*)(V + (size_t)(r0 + s) * D + c); const float mean = ST[2 * s], rstd = ST[2 * s + 1];
                  vn[s][0] = (bflo(w) - mean) * rstd * gg.x + bb.x; vn[s][1] = (bfhi(w) - mean) * rstd * gg.y + bb.y;
                  f32x2 o; o.x = vn[s][0]; o.y = vn[s][1]; *(f32x2*)(out + O_NV + ((size_t)j * MS + T_S * b + s) * D + c) = o; }
#pragma unroll
              for (int t = 0; t < T_S; ++t) { const float bs = b_sp[h * CHUNK + t]; float a0 = bs, a1 = bs;
#pragma unroll
                  for (int s = 0; s <= t; ++s) { const float wgt = w_sp[((size_t)h * CHUNK + t) * CHUNK + s]; a0 += wgt * vn[s][0]; a1 += wgt * vn[s][1]; }
                  const unsigned uu = *(const unsigned*)(U + (size_t)(r0 + t) * D + c); *(unsigned*)(Y + (size_t)(r0 + t) * D + c) = pk2(bflo(uu) * a0, bfhi(uu) * a1); } }
            __syncthreads();
        }
    }
}
#define GRID_SYNC() grid.sync()
#define GEMM_PHASE(EpiT, Aptr, Bptr, Mv, Nv, Kv, Eobj) do { pg8::Gemm g_{(const pg8::bf16_t*)(Aptr), (const pg8::bf16_t*)(Bptr), (Mv), (Nv), (Kv)}; pg8::StaticOrder S_; S_.init((Mv), (Nv), G, bid); \
    pg8::gemm_phase<EpiT, pg8::StaticOrder, true, true>(lds, g_, S_, (Eobj)); } while (0)

__global__ void __launch_bounds__(NTHREADS, 2) mega_fwd(Args a) {
    extern __shared__ __attribute__((aligned(16))) unsigned char lds_raw[];
    LAS unsigned char* lds = (LAS unsigned char*)lds_raw;
    cg::grid_group grid = cg::this_grid();
    constexpr int NPH = 3 + 7 * DEPTH;
    for (int ph = 0; ph < NPH; ++ph) {
        int p = ph, G = gridDim.x, bid = blockIdx.x; asm volatile("" : "+s"(p), "+s"(G), "+s"(bid));
        unsigned char* ws = a.ws; float* out = a.out;
        float* MODG = (float*)(ws + WS_MODG); float* X = (float*)(ws + WS_X); bf16* H = (bf16*)(ws + WS_H);
        bf16* Z0 = (bf16*)(ws + WS_Z0); bf16* Z1 = (bf16*)(ws + WS_Z1); bf16* CAT = (bf16*)(ws + WS_CAT); bf16* HID = (bf16*)(ws + WS_HID); float* VSTAT = (float*)(ws + WS_VSTAT);
        if (p == 0) {
            prologue_phase(a, lds, bid, G);
        } else if (p == 1) {
            pg8::EpiMod E{MODG, a.in[I_BADA]}; GEMM_PHASE(pg8::EpiMod, ws + WS_CSILU, ws + WS_WADA, 256, MODLD, D, E);
        } else {
            const int qq = p + 4, l = qq / 7 - 1, k = qq - 7 * (l + 1), half = l >> 1; const bool even = (l & 1) == 0;
            const float* modl = MODG + (size_t)l * 6 * D;
            if (k == 0) {
                if (even) { pg8::EpiGlu E{Z0}; GEMM_PHASE(pg8::EpiGlu, H, (bf16*)(ws + WS_WINE) + (size_t)half * NZ_E * D, M, NZ_E, D, E); }
                else { pg8::EpiUV E{Z0, Z1, VSTAT}; GEMM_PHASE(pg8::EpiUV, H, (bf16*)(ws + WS_WINO) + (size_t)half * NZ_O * D, M, NZ_O, D, E); }
            } else if (k == 1) {
                if (even) mix_even_phase(lds, half, Z0, CAT, a.in[I_SCONV] + (size_t)half * NB_S * NHIST_C * DA, a.in[I_SPOOL] + (size_t)half * NB_S * NHIST_P * DB, a.in[I_WDW] + (size_t)half * CONVW * DA, a.in[I_BDW] + (size_t)half * DA,
                                         a.in[I_GCLN] + (size_t)half * DA, a.in[I_BCLN] + (size_t)half * DA, (bf16*)(ws + WS_WPOOL) + (size_t)half * 4 * 128 * 128, a.in[I_SPOOLS] + (size_t)half * DB, out, bid, G);
                else mix_odd_phase(lds, half, Z0, Z1, VSTAT, CAT, a.in[I_GV] + (size_t)half * D, a.in[I_BV] + (size_t)half * D, (bf16*)(ws + WS_WSP) + (size_t)half * HC * CHUNK * CHUNK,
                                   a.in[I_WSP] + (size_t)half * HC * CHUNK * CHUNK, a.in[I_BSP] + (size_t)half * HC * CHUNK, out, bid, G);
            } else if (k == 2 || k == 5) {
                const bool mixer = (k == 2), first = mixer && l == 0;
                const bf16* A = mixer ? CAT : HID;
                const bf16* Bt = mixer ? (even ? (bf16*)(ws + WS_WOUTE) : (bf16*)(ws + WS_WOUTO)) + (size_t)half * D * D : (bf16*)(ws + WS_W2) + (size_t)l * D * FF;
                pg8::EpiRes E{first ? a.in[I_XP] : X, first ? a.in[I_XS] : X + (size_t)MP * D, X, modl + (mixer ? 2 : 5) * D};
                GEMM_PHASE(pg8::EpiRes, A, Bt, M, D, mixer ? D : FF, E);
            } else if (k == 4) {
                pg8::EpiRelu2 E{HID}; GEMM_PHASE(pg8::EpiRelu2, H, (bf16*)(ws + WS_W1) + (size_t)l * FF * D, M, FF, D, E);
            } else if (k == 6 && l == DEPTH - 1) {
                norm_phase<true>(X, X + (size_t)MP * D, a.in[I_GFINAL], nullptr, 0, 0, nullptr, out + O_YP, bid, G);
            } else {
                const bool nxt = (k == 6), fromin = nxt && l < 0;
                norm_phase<false>(fromin ? a.in[I_XP] : X, fromin ? a.in[I_XS] : X + (size_t)MP * D, nxt ? a.in[I_GMIX] + (size_t)(l + 1) * D : a.in[I_GFFN] + (size_t)l * D,
                                  nxt ? modl + 6 * D : modl, nxt ? 0 : 3, nxt ? 1 : 4, H, nullptr, bid, G);
            }
        }
        if (ph < NPH - 1) GRID_SYNC();
    }
}

extern "C" void kernel_launch(void* const* d_in, const int* in_sizes, int n_in, void* d_out, int out_size, void* d_ws, size_t ws_size, hipStream_t stream) {
    static int grid = 0;
    if (grid == 0) {
        if (n_in != N_INPUTS || (size_t)out_size != O_END || ws_size < WS_END) { fprintf(stderr, "kernel_launch: unexpected shapes: n_in %d out %d ws %zu (need %zu)\n", n_in, out_size, ws_size, (size_t)WS_END); grid = -1; return; }
        int dev = 0, cus = 0, per_cu = 0;
        if (hipGetDevice(&dev) != hipSuccess || hipDeviceGetAttribute(&cus, hipDeviceAttributeMultiprocessorCount, dev) != hipSuccess) { grid = -1; return; }
        if (hipFuncSetAttribute((const void*)mega_fwd, hipFuncAttributeMaxDynamicSharedMemorySize, LDS_BYTES) != hipSuccess) { fprintf(stderr, "kernel_launch: hipFuncSetAttribute failed\n"); grid = -1; return; }
        if (hipOccupancyMaxActiveBlocksPerMultiprocessor(&per_cu, (const void*)mega_fwd, NTHREADS, LDS_BYTES) != hipSuccess || per_cu < 1) { fprintf(stderr, "kernel_launch: occupancy query says %d blocks per CU\n", per_cu); grid = -1; (void)hipGetLastError(); return; }
        grid = cus;
    }
    if (grid < 0) return;
    Args a{};
    for (int i = 0; i < N_INPUTS; ++i) a.in[i] = (const float*)d_in[i];
    a.out = (float*)d_out; a.ws = (unsigned char*)d_ws;
    void* args[] = {&a};
    hipError_t e = hipLaunchCooperativeKernel((const void*)mega_fwd, dim3(grid), dim3(NTHREADS), args, LDS_BYTES, stream);
    if (e != hipSuccess) fprintf(stderr, "kernel_launch: cooperative launch failed: %s (grid %d)\n", hipGetErrorString(e), grid);
}
```

```cpp
#include <hip/hip_runtime.h>
#include <hip/hip_cooperative_groups.h>
#include <cstdio>
#include <cstdint>
namespace cg = cooperative_groups;

constexpr int D = 1024, NB_P = 8, T_P = 2048, NB_S = 128, T_S = 4, DEPTH = 4;
constexpr int MP = NB_P * T_P, MS = NB_S * T_S, M = MP + MS;
constexpr int NMODROWS = NB_P + NB_S;
constexpr int DA = 512, DB = 512, CONVW = 31, NHIST_C = 30, NHIST_P = 15, FF = 4096, NZ_E = 1536, NZ_O = 2048;
constexpr int HC = 8, DHC = 128, CHUNK = 128, PAST = 16384;
constexpr float EPS = 1e-6f;
constexpr int MODLD = DEPTH * 6 * D;

enum { I_XP = 0, I_XS, I_CP, I_CS, I_SCONV, I_SPOOL, I_WADA, I_BADA, I_GMIX, I_GFFN, I_WINAB, I_WDW, I_BDW, I_GCLN, I_BCLN,
       I_WPOOL, I_SPOOLS, I_WOUTAB, I_WINC, I_GV, I_BV, I_WSP, I_BSP, I_WOUTC, I_WFFN1, I_WFFN2, I_GFINAL, N_INPUTS };

constexpr size_t O_YP = 0, O_YS = O_YP + (size_t)MP * D, O_NCP = O_YS + (size_t)MS * D, O_NPP = O_NCP + (size_t)2 * NB_P * NHIST_C * DA,
                 O_NCS = O_NPP + (size_t)2 * NB_P * NHIST_P * DB, O_NPS = O_NCS + (size_t)2 * NB_S * NHIST_C * DA,
                 O_NV = O_NPS + (size_t)2 * NB_S * NHIST_P * DB, O_END = O_NV + (size_t)2 * NB_S * T_S * D;

__device__ __forceinline__ int modrow_of(int r) { return r < MP ? (r >> 11) : NB_P + ((r - MP) >> 2); }
namespace pg8 {
#define PG8_LAS __attribute__((address_space(3)))
typedef unsigned short bf16_t;
typedef short bf16x8 __attribute__((ext_vector_type(8)));
typedef float f32x4 __attribute__((ext_vector_type(4)));
typedef unsigned u32x4 __attribute__((ext_vector_type(4)));
constexpr int BM = 256, BK = 64, HALF = 128, HTB = HALF * BK * 2  , STAGE_BYTES = 8 * HTB, NXCD = 8, WGM = 8;

__host__ __device__ __forceinline__ int lds_byte(int r, int c) { const int st = (r >> 4) * 2 + (c >> 5), rr = r & 15, cc = c & 31, ob = rr * 64 + cc * 2; return st * 1024 + (ob ^ (((ob >> 9) & 1) << 5)); }
__host__ __device__ __forceinline__ void stage_rc(int b, int& R, int& C) { const int st = b / 1024, sb = b % 1024, swz = sb ^ (((sb >> 9) & 1) << 5); R = (st >> 1) * 16 + swz / 64; C = (st & 1) * 32 + (swz % 64) / 2; }
__host__ __device__ __forceinline__ int perm32(int rho) { const int n = rho >> 4, i = rho & 15; return 8 * (i >> 2) + 4 * n + (i & 3); }

struct Unit { int pm, pn; };
struct Gemm { const bf16_t* A; const bf16_t* Bt; int M, N, K; };

struct StaticOrder {
    int nM, nN, nwg, G, c;
    __host__ __device__ void init(int M, int N, int G_, int c_) { nM = M / BM; nN = N / BM; nwg = nM * nN; G = G_; c = c_; }
    __host__ __device__ bool next(int i, Unit& u) const {
        const long L = (long)i * G + c; if (L >= nwg) return false;
        int wgid = (int)L; { const int q = nwg / NXCD, r = nwg % NXCD, xcd = wgid % NXCD, off = wgid / NXCD; wgid = (xcd < r ? xcd * (q + 1) : r * (q + 1) + (xcd - r) * q) + off; }
        const int nig = WGM * nN, gid = wgid / nig, fm = gid * WGM, gsz = (nM - fm) < WGM ? (nM - fm) : WGM;
        u.pm = fm + ((wgid % nig) % gsz); u.pn = (wgid % nig) / gsz; return true;
    }
    __device__ __forceinline__ void a_ready(const Unit&) const {}
    __device__ __forceinline__ void done(const Unit&) const {}
};

__device__ __forceinline__ unsigned cvt_pk_bf16(float lo, float hi) { unsigned r; asm volatile("v_cvt_pk_bf16_f32 %0, %1, %2" : "=v"(r) : "v"(lo), "v"(hi)); return r; }
typedef float f32x2 __attribute__((ext_vector_type(2)));
__device__ __forceinline__ float sigmoid_fast(float v) { return __builtin_amdgcn_rcpf(1.0f + __expf(-v)); }
struct EpiGlu {
    static constexpr bool PERM = true, AFTER_DRAIN = false;
    bf16_t* Z;
    __device__ __forceinline__ void operator()(const f32x4 (&acc)[2][2][4][2], const Unit& u, int wr, int wc, int fr, int fq) const {
        const int row0 = u.pm * BM + wr * 64 + fr, cw = wc * 32 + 8 * fq;
        if (u.pn < 4) {
#pragma unroll
            for (int ai = 0; ai < 2; ++ai)
#pragma unroll
                for (int m = 0; m < 4; ++m) { bf16_t* rowp = Z + (size_t)(row0 + ai * HALF + m * 16) * D + 128 * u.pn + cw;
                    const f32x4 v0 = acc[ai][0][m][0], v1 = acc[ai][0][m][1], g0 = acc[ai][1][m][0], g1 = acc[ai][1][m][1]; float a[8];
#pragma unroll
                    for (int j = 0; j < 4; ++j) { a[j] = v0[j] * sigmoid_fast(g0[j]); a[4 + j] = v1[j] * sigmoid_fast(g1[j]); }
                    u32x4 w; w.x = cvt_pk_bf16(a[0], a[1]); w.y = cvt_pk_bf16(a[2], a[3]); w.z = cvt_pk_bf16(a[4], a[5]); w.w = cvt_pk_bf16(a[6], a[7]);
                    *(u32x4*)rowp = w; }
        } else {
#pragma unroll
            for (int ai = 0; ai < 2; ++ai)
#pragma unroll
                for (int m = 0; m < 4; ++m) { bf16_t* rowp = Z + (size_t)(row0 + ai * HALF + m * 16) * D + 512 + 256 * (u.pn - 4) + cw;
#pragma unroll
                    for (int bj = 0; bj < 2; ++bj) { const f32x4 v0 = acc[ai][bj][m][0], v1 = acc[ai][bj][m][1];
                        u32x4 w; w.x = cvt_pk_bf16(v0[0], v0[1]); w.y = cvt_pk_bf16(v0[2], v0[3]); w.z = cvt_pk_bf16(v1[0], v1[1]); w.w = cvt_pk_bf16(v1[2], v1[3]);
                        *(u32x4*)(rowp + bj * HALF) = w; } }
        }
    }
};
struct EpiUV {
    static constexpr bool PERM = true, AFTER_DRAIN = false;
    bf16_t* U; bf16_t* V; float* vstat;
    __device__ __forceinline__ void operator()(const f32x4 (&acc)[2][2][4][2], const Unit& u, int wr, int wc, int fr, int fq) const {
        const int row0 = u.pm * BM + wr * 64 + fr, cw = wc * 32 + 8 * fq; const bool isv = u.pn >= 4;
        bf16_t* base = (isv ? V + 256 * (u.pn - 4) : U + 256 * u.pn) + cw;
#pragma unroll
        for (int ai = 0; ai < 2; ++ai)
#pragma unroll
            for (int m = 0; m < 4; ++m) { const int row = row0 + ai * HALF + m * 16; bf16_t* rowp = base + (size_t)row * D; float s = 0.f, q = 0.f;
#pragma unroll
                for (int bj = 0; bj < 2; ++bj) { const f32x4 v0 = acc[ai][bj][m][0], v1 = acc[ai][bj][m][1];
                    u32x4 w; w.x = cvt_pk_bf16(v0[0], v0[1]); w.y = cvt_pk_bf16(v0[2], v0[3]); w.z = cvt_pk_bf16(v1[0], v1[1]); w.w = cvt_pk_bf16(v1[2], v1[3]);
                    *(u32x4*)(rowp + bj * HALF) = w;
                    s += (v0[0] + v0[1]) + (v0[2] + v0[3]) + (v1[0] + v1[1]) + (v1[2] + v1[3]);
                    q += (v0[0] * v0[0] + v0[1] * v0[1]) + (v0[2] * v0[2] + v0[3] * v0[3]) + (v1[0] * v1[0] + v1[1] * v1[1]) + (v1[2] * v1[2] + v1[3] * v1[3]); }
                if (isv) { s += __shfl_xor(s, 16); s += __shfl_xor(s, 32); q += __shfl_xor(q, 16); q += __shfl_xor(q, 32);
                    if (fq == 0) { f32x2 o; o.x = s; o.y = q; *(f32x2*)(vstat + ((size_t)row * 16 + (u.pn - 4) * 4 + wc) * 2) = o; } } }
    }
};
struct EpiRes {
    static constexpr bool PERM = false, AFTER_DRAIN = false;
    const float* xin_p; const float* xin_s; float* xout; const float* gate;
    __device__ __forceinline__ void operator()(const f32x4 (&acc)[2][2][4][2], const Unit& u, int wr, int wc, int fr, int fq) const {
        const int col0 = u.pn * BM + wc * 32 + 4 * fq;
#pragma unroll
        for (int ai = 0; ai < 2; ++ai)
#pragma unroll
            for (int m = 0; m < 4; ++m) { const int r = u.pm * BM + ai * HALF + wr * 64 + m * 16 + fr; const float* g = gate + (size_t)modrow_of(r) * MODLD + col0;
                const float* xi = (r < MP ? xin_p + (size_t)r * D : xin_s + (size_t)(r - MP) * D) + col0; float* xo = xout + (size_t)r * D + col0;
#pragma unroll
                for (int bj = 0; bj < 2; ++bj)
#pragma unroll
                    for (int n = 0; n < 2; ++n) { const int o = bj * HALF + n * 16; const f32x4 gv = *(const f32x4*)(g + o), xv = *(const f32x4*)(xi + o);
                        *(f32x4*)(xo + o) = xv + gv * acc[ai][bj][m][n]; } }
    }
};
struct EpiRelu2 {
    static constexpr bool PERM = true, AFTER_DRAIN = false;
    bf16_t* O;
    __device__ __forceinline__ void operator()(const f32x4 (&acc)[2][2][4][2], const Unit& u, int wr, int wc, int fr, int fq) const {
        const int row0 = u.pm * BM + wr * 64 + fr, col0 = u.pn * BM + wc * 32 + 8 * fq;
#pragma unroll
        for (int ai = 0; ai < 2; ++ai)
#pragma unroll
            for (int m = 0; m < 4; ++m) { bf16_t* rowp = O + (size_t)(row0 + ai * HALF + m * 16) * FF + col0;
#pragma unroll
                for (int bj = 0; bj < 2; ++bj) { f32x4 v0 = acc[ai][bj][m][0], v1 = acc[ai][bj][m][1];
#pragma unroll
                    for (int j = 0; j < 4; ++j) { const float a = fmaxf(v0[j], 0.f), b = fmaxf(v1[j], 0.f); v0[j] = a * a; v1[j] = b * b; }
                    u32x4 w; w.x = cvt_pk_bf16(v0[0], v0[1]); w.y = cvt_pk_bf16(v0[2], v0[3]); w.z = cvt_pk_bf16(v1[0], v1[1]); w.w = cvt_pk_bf16(v1[2], v1[3]);
                    *(u32x4*)(rowp + bj * HALF) = w; } }
    }
};
struct EpiMod {
    static constexpr bool PERM = false, AFTER_DRAIN = false;
    float* C; const float* bias;
    __device__ __forceinline__ void operator()(const f32x4 (&acc)[2][2][4][2], const Unit& u, int wr, int wc, int fr, int fq) const {
        const int col0 = u.pn * BM + wc * 32 + 4 * fq;
#pragma unroll
        for (int ai = 0; ai < 2; ++ai)
#pragma unroll
            for (int m = 0; m < 4; ++m) { const int r = ai * HALF + wr * 64 + m * 16 + fr;
                if (r < NMODROWS) { float* rowp = C + (size_t)r * MODLD + col0;
#pragma unroll
                    for (int bj = 0; bj < 2; ++bj)
#pragma unroll
                        for (int n = 0; n < 2; ++n) { const int o = bj * HALF + n * 16; *(f32x4*)(rowp + o) = acc[ai][bj][m][n] + *(const f32x4*)(bias + col0 + o); } } }
    }
};
template <class Epi, class Sched, bool ALIGN_EPI = false, bool SP2 = false>
__device__ __forceinline__ void gemm_phase(PG8_LAS unsigned char* lds, const Gemm g, const Sched& S, const Epi& E) {
    int tid_ = threadIdx.x; asm volatile("" : "+v"(tid_));
    const int tid = tid_, wid = __builtin_amdgcn_readfirstlane(tid >> 6), lane = tid & 63, wr = wid >> 2, wc = wid & 3, fr = lane & 15, fq = lane >> 4;
    const int K = g.K, nt = K / BK;
    unsigned voffA[2], voffB[2];
#pragma unroll
    for (int i = 0; i < 2; ++i) { int R, C; stage_rc(tid * 16 + i * 8192, R, C); const int Rb = Epi::PERM ? ((R & ~31) + perm32(R & 31)) : R;
        voffA[i] = (unsigned)(R * K + C) * 2u; voffB[i] = (unsigned)(Rb * K + C) * 2u; }
    const size_t kstep = (size_t)(BK * 2);
    const size_t hstep = (size_t)HALF * K * 2;
    const size_t tstep = 2 * hstep;
    const unsigned ldsw = (unsigned)wid * 1024u;
    const int aoff = lds_byte(wr * 64 + fr, fq * 8), boff = lds_byte(wc * 32 + fr, fq * 8);
#define PG8_SA(b, h) (((b) * 2 + (h)) * HTB)
#define PG8_SB(b, h) ((4 + (b) * 2 + (h)) * HTB)
#define PG8_STAGE(bufoff, gbase, voff) do { _Pragma("unroll") for (int _i = 0; _i < 2; ++_i) \
        __builtin_amdgcn_global_load_lds((const unsigned*)((const char*)(gbase) + (voff)[_i]), (PG8_LAS unsigned*)(lds + (bufoff) + ldsw + _i * 8192), 16, 0, 0); } while (0)
#define PG8_LDA(dst, b, h) do { _Pragma("unroll") for (int m = 0; m < 4; ++m) _Pragma("unroll") for (int k = 0; k < 2; ++k) dst[m][k] = *(const PG8_LAS bf16x8*)(lds + PG8_SA(b, h) + aoff + m * 2048 + k * 1024); } while (0)
#define PG8_LDB(dst, b, h) do { _Pragma("unroll") for (int n = 0; n < 2; ++n) _Pragma("unroll") for (int k = 0; k < 2; ++k) dst[n][k] = *(const PG8_LAS bf16x8*)(lds + PG8_SB(b, h) + boff + n * 2048 + k * 1024); } while (0)
#define PG8_MMA(ai, bj, At, Bt) do { __builtin_amdgcn_s_setprio(1); _Pragma("unroll") for (int m = 0; m < 4; ++m) _Pragma("unroll") for (int n = 0; n < 2; ++n) _Pragma("unroll") for (int k = 0; k < 2; ++k) \
        acc[ai][bj][m][n] = __builtin_amdgcn_mfma_f32_16x16x32_bf16(Bt[n][k], At[m][k], acc[ai][bj][m][n], 0, 0, 0); __builtin_amdgcn_s_setprio(0); } while (0)
#define PG8_WAIT_V(n) asm volatile("s_waitcnt vmcnt(" #n ")" ::: "memory")
#define PG8_WAIT_L(n) asm volatile("s_waitcnt lgkmcnt(" #n ")" ::: "memory")
#define PG8_BAR __builtin_amdgcn_s_barrier()
#define PG8_SCHED __builtin_amdgcn_sched_barrier(0)
    Unit cur, nxt; int ui = 0;
    if (!S.next(0, cur)) return;
    f32x4 acc[2][2][4][2];
#pragma unroll
    for (int a = 0; a < 2; ++a)
#pragma unroll
        for (int b = 0; b < 2; ++b)
#pragma unroll
            for (int m = 0; m < 4; ++m)
#pragma unroll
                for (int n = 0; n < 2; ++n) acc[a][b][m][n] = (f32x4){0.f, 0.f, 0.f, 0.f};
    bf16x8 At[4][2], B0[2][2], B1[2][2];
    const char* cA = (const char*)g.A + (size_t)cur.pm * tstep; const char* cB = (const char*)g.Bt + (size_t)cur.pn * tstep;
    S.a_ready(cur);
    if constexpr (SP2) {
        PG8_STAGE(PG8_SB(0, 0), cB, voffB); PG8_STAGE(PG8_SB(0, 1), cB + hstep, voffB); PG8_STAGE(PG8_SA(0, 0), cA, voffA); PG8_STAGE(PG8_SA(0, 1), cA + hstep, voffA);
        if (wr == 1) PG8_BAR;
        PG8_WAIT_V(2); PG8_BAR;
        PG8_STAGE(PG8_SB(1, 0), cB + kstep, voffB); PG8_STAGE(PG8_SA(1, 0), cA + kstep, voffA); PG8_STAGE(PG8_SB(1, 1), cB + hstep + kstep, voffB);
        PG8_WAIT_V(6); PG8_BAR;
    } else {
        PG8_STAGE(PG8_SB(0, 0), cB, voffB); PG8_STAGE(PG8_SA(0, 0), cA, voffA); PG8_STAGE(PG8_SB(0, 1), cB + hstep, voffB); PG8_STAGE(PG8_SA(0, 1), cA + hstep, voffA);
        if (wr == 1) PG8_BAR;
        PG8_WAIT_V(4); PG8_BAR;
        PG8_STAGE(PG8_SB(1, 0), cB + kstep, voffB); PG8_STAGE(PG8_SA(1, 0), cA + kstep, voffA); PG8_STAGE(PG8_SB(1, 1), cB + hstep + kstep, voffB);
        PG8_WAIT_V(6); PG8_BAR;
    }
    for (;;) {
        const bool has_next = S.next(ui + 1, nxt);
        const char* nA = has_next ? (const char*)g.A + (size_t)nxt.pm * tstep : cA; const char* nB = has_next ? (const char*)g.Bt + (size_t)nxt.pn * tstep : cB;
        for (int t = 0; t < nt; t += 2) {
            const bool last = (t == nt - 2);
            const char* a1 = cA + (size_t)(t + 1) * kstep;
            const char* a2 = last ? nA : cA + (size_t)(t + 2) * kstep; const char* b2 = last ? nB : cB + (size_t)(t + 2) * kstep;
            const char* a3 = a2 + kstep; const char* b3 = b2 + kstep;
            if (last && has_next) S.a_ready(nxt);
            if constexpr (SP2) {
            PG8_LDB(B0, 0, 0); PG8_LDB(B1, 0, 1); PG8_SCHED; PG8_LDA(At, 0, 0); PG8_STAGE(PG8_SA(1, 1), a1 + hstep, voffA);
            PG8_WAIT_V(8); PG8_WAIT_L(0); PG8_BAR; PG8_MMA(0, 0, At, B0); PG8_MMA(0, 1, At, B1); PG8_BAR; PG8_SCHED;
            PG8_LDA(At, 0, 1); PG8_STAGE(PG8_SB(0, 0), b2, voffB); PG8_STAGE(PG8_SB(0, 1), b2 + hstep, voffB); PG8_STAGE(PG8_SA(0, 0), a2, voffA);
            PG8_WAIT_V(8); PG8_WAIT_L(0); PG8_BAR; PG8_MMA(1, 0, At, B0); PG8_MMA(1, 1, At, B1); PG8_BAR; PG8_SCHED;
            PG8_LDB(B0, 1, 0); PG8_LDB(B1, 1, 1); PG8_SCHED; PG8_LDA(At, 1, 0); PG8_STAGE(PG8_SA(0, 1), a2 + hstep, voffA);
            PG8_WAIT_V(8); PG8_WAIT_L(0); PG8_BAR; PG8_MMA(0, 0, At, B0); PG8_MMA(0, 1, At, B1); PG8_BAR; PG8_SCHED;
            PG8_LDA(At, 1, 1); PG8_STAGE(PG8_SB(1, 0), b3, voffB); PG8_STAGE(PG8_SB(1, 1), b3 + hstep, voffB); PG8_STAGE(PG8_SA(1, 0), a3, voffA);
            PG8_WAIT_V(8); PG8_WAIT_L(0); PG8_BAR; PG8_MMA(1, 0, At, B0); PG8_MMA(1, 1, At, B1); PG8_BAR; PG8_SCHED;
            } else {
            PG8_LDB(B0, 0, 0); PG8_SCHED; PG8_LDA(At, 0, 0); PG8_STAGE(PG8_SA(1, 1), a1 + hstep, voffA);
            PG8_WAIT_L(8); PG8_BAR; PG8_WAIT_L(0); PG8_MMA(0, 0, At, B0); PG8_BAR; PG8_SCHED;
            PG8_LDB(B1, 0, 1); PG8_STAGE(PG8_SB(0, 0), b2, voffB);
            PG8_BAR; PG8_WAIT_L(0); PG8_MMA(0, 1, At, B1); PG8_BAR;
            PG8_LDA(At, 0, 1); PG8_STAGE(PG8_SA(0, 0), a2, voffA);
            PG8_BAR; PG8_WAIT_L(0); PG8_MMA(1, 0, At, B0); PG8_BAR; PG8_SCHED;
            PG8_STAGE(PG8_SB(0, 1), b2 + hstep, voffB);
            PG8_WAIT_V(6); PG8_BAR; PG8_MMA(1, 1, At, B1); PG8_BAR;
            PG8_LDB(B0, 1, 0); PG8_SCHED; PG8_LDA(At, 1, 0); PG8_STAGE(PG8_SA(0, 1), a2 + hstep, voffA);
            PG8_WAIT_L(8); PG8_BAR; PG8_WAIT_L(0); PG8_MMA(0, 0, At, B0); PG8_BAR; PG8_SCHED;
            PG8_LDB(B1, 1, 1); PG8_STAGE(PG8_SB(1, 0), b3, voffB);
            PG8_BAR; PG8_WAIT_L(0); PG8_MMA(0, 1, At, B1); PG8_BAR;
            PG8_LDA(At, 1, 1); PG8_STAGE(PG8_SA(1, 0), a3, voffA);
            PG8_BAR; PG8_WAIT_L(0); PG8_MMA(1, 0, At, B0); PG8_BAR; PG8_SCHED;
            PG8_STAGE(PG8_SB(1, 1), b3 + hstep, voffB);
            PG8_WAIT_V(6); PG8_BAR; PG8_MMA(1, 1, At, B1); PG8_BAR;
            }
        }
        if constexpr (ALIGN_EPI) { if (wr == 0) PG8_BAR; }
        if constexpr (!Epi::AFTER_DRAIN) { E(acc, cur, wr, wc, fr, fq); S.done(cur); }
        if (!has_next) break;
#pragma unroll
        for (int a = 0; a < 2; ++a)
#pragma unroll
            for (int b = 0; b < 2; ++b)
#pragma unroll
                for (int m = 0; m < 4; ++m)
#pragma unroll
                    for (int n = 0; n < 2; ++n) acc[a][b][m][n] = (f32x4){0.f, 0.f, 0.f, 0.f};
        cur = nxt; cA = nA; cB = nB; ++ui;
        if constexpr (ALIGN_EPI) { if (wr == 1) PG8_BAR; }
    }
    PG8_WAIT_V(0);
    if constexpr (!ALIGN_EPI) { if (wr == 0) PG8_BAR; }
    PG8_BAR;
    if constexpr (Epi::AFTER_DRAIN) { E.fused(acc, cur, wr, wc, fr, fq, lds, wid, lane); S.done(cur); }
#undef PG8_SA
#undef PG8_SB
#undef PG8_STAGE
#undef PG8_LDA
#undef PG8_LDB
#undef PG8_MMA
#undef PG8_WAIT_V
#undef PG8_WAIT_L
#undef PG8_BAR
#undef PG8_SCHED
}
}
#define GAS __attribute__((address_space(1)))
#define LAS __attribute__((address_space(3)))
typedef unsigned short bf16;
typedef unsigned v4u __attribute__((ext_vector_type(4)));
typedef unsigned v2u __attribute__((ext_vector_type(2)));
typedef float f32x4 __attribute__((ext_vector_type(4)));
typedef float f32x2 __attribute__((ext_vector_type(2)));
typedef short bf16x8 __attribute__((ext_vector_type(8)));
typedef short s16x4 __attribute__((ext_vector_type(4)));
#define LDS_WAIT() asm volatile("s_waitcnt lgkmcnt(0)" ::: "memory")
#define VM_WAIT() asm volatile("s_waitcnt vmcnt(0)" ::: "memory")
__device__ __forceinline__ unsigned f2bf(float f) { unsigned u = __builtin_bit_cast(unsigned, f); return (u + 0x7fffu + ((u >> 16) & 1u)) >> 16; }
__device__ __forceinline__ unsigned pk2(float lo, float hi) { return f2bf(lo) | (f2bf(hi) << 16); }
__device__ __forceinline__ float bflo(unsigned w) { return __builtin_bit_cast(float, w << 16); }
__device__ __forceinline__ float bfhi(unsigned w) { return __builtin_bit_cast(float, w & 0xffff0000u); }
__device__ __forceinline__ float bf1(bf16 h) { return __builtin_bit_cast(float, (unsigned)h << 16); }
__device__ __forceinline__ float wave_sum(float v) {
#pragma unroll
    for (int o = 1; o < 64; o <<= 1) v += __shfl_xor(v, o);
    return v;
}
__device__ __forceinline__ float silu_f(float v) { return v / (1.0f + __expf(-v)); }

constexpr size_t MiB = 1u << 20;
constexpr size_t WS_CTL = 0;
constexpr size_t WS_WINE = 1 * MiB;
constexpr size_t WS_WOUTE = 7 * MiB;
constexpr size_t WS_WINO = 11 * MiB;
constexpr size_t WS_WOUTO = 19 * MiB;
constexpr size_t WS_W1 = 23 * MiB;
constexpr size_t WS_W2 = 55 * MiB;
constexpr size_t WS_WPOOL = 87 * MiB;
constexpr size_t WS_WSP = 87 * MiB + 512 * 1024;
constexpr size_t WS_CSILU = 88 * MiB;
constexpr size_t WS_VSTAT = 89 * MiB;
constexpr size_t WS_MODG = 92 * MiB;
constexpr size_t WS_X = 105 * MiB;
constexpr size_t WS_H = 171 * MiB;
constexpr size_t WS_R = 204 * MiB;
constexpr size_t WS_Z0 = WS_R, WS_Z1 = WS_R + 33 * MiB, WS_CAT = WS_R + 66 * MiB, WS_WADA = WS_R, WS_HID = WS_R;
constexpr size_t WS_END = WS_R + 132 * MiB;
static_assert((size_t)M * D * 2 <= 33 * MiB && (size_t)M * FF * 2 <= 132 * MiB && (size_t)NMODROWS * MODLD * 4 <= 13 * MiB && (size_t)M * 32 * 4 <= 3 * MiB, "ws map");

constexpr int NWAVES = 8, NTHREADS = 512;
constexpr int LDS_BYTES = 147456;

struct Args { const float* in[N_INPUTS]; float* out; unsigned char* ws; };
#define XB_TMO      128
#define XB_XCNT(j)  (256  + 64 * (j))
#define XB_XSUB(j)  (1280 + 64 * (j))
#define XB_XGEN(j)  (2304 + 64 * (j))
#define XB_TOP      3328
#define XB_TOPGEN   3392
#define XCD_BAR_WORDS 3456
#define XB_SPIN_CAP (1u << 18)

__device__ __forceinline__ unsigned xb_ld(unsigned* p)              { return __hip_atomic_load(p, __ATOMIC_RELAXED, __HIP_MEMORY_SCOPE_AGENT); }
__device__ __forceinline__ unsigned xb_add(unsigned* p, unsigned v) { return __hip_atomic_fetch_add(p, v, __ATOMIC_RELAXED, __HIP_MEMORY_SCOPE_AGENT); }
__device__ __forceinline__ unsigned xb_xcc_id() { return (unsigned)__builtin_amdgcn_s_getreg((3 << 11) | 20) & 0xFu; }
#define XB_SPIN(cond, bar) do { unsigned _sp = 0; while (cond) { __builtin_amdgcn_s_sleep(1); \
    if ((++_sp & 255u) == 0u) { if (xb_ld(&(bar)[XB_TMO])) break; if (_sp > XB_SPIN_CAP) { atomicAdd(&(bar)[XB_TMO], 1u); break; } } } } while (0)

struct XcdBarrier {
    unsigned* bar; unsigned x;
    volatile LAS unsigned* st;
};

__device__ __forceinline__ XcdBarrier xcd_barrier_post(unsigned* bar, volatile LAS unsigned* st) {
    XcdBarrier b; b.bar = bar; b.x = xb_xcc_id(); b.st = st;
    if (threadIdx.x == 0) (void)xb_add(&bar[XB_XCNT(b.x)], 1u);
    return b;
}
__device__ __forceinline__ void xcd_barrier_complete(unsigned* bar, unsigned x, unsigned& nloc, unsigned& nx) {
    const unsigned G = gridDim.x * gridDim.y * gridDim.z;
    unsigned sum, cnt, mine, sp = 0u;
    for (;;) {
        sum = 0u; cnt = 0u; mine = 0u;
#pragma unroll
        for (unsigned j = 0; j < 16; ++j) { const unsigned c = xb_ld(&bar[XB_XCNT(j)]); sum += c; cnt += (c > 0u) ? 1u : 0u; mine = (j == x) ? c : mine; }
        if (sum == G) break;
        __builtin_amdgcn_s_sleep(1);
        if ((++sp & 255u) == 0u) { if (xb_ld(&bar[XB_TMO])) break; if (sp > XB_SPIN_CAP) { atomicAdd(&bar[XB_TMO], 1u); break; } }
    }
    nloc = mine > 0u ? mine : 1u; nx = cnt > 0u ? cnt : 1u;
}

__device__ __forceinline__ void xcd_barrier(const XcdBarrier& b) {
    asm volatile("s_waitcnt vmcnt(0)" ::: "memory");
    __syncthreads();
    if (threadIdx.x == 0) {
        unsigned* bar = b.bar;
        __builtin_amdgcn_s_waitcnt(0);
        unsigned nloc = b.st[0], nx = b.st[1];
        if (nloc == 0u) { xcd_barrier_complete(bar, b.x, nloc, nx); b.st[0] = nloc; b.st[1] = nx; }
        const unsigned old = xb_add(&bar[XB_XSUB(b.x)], 1u);
        const unsigned gen = old / nloc;
        if (old + 1u == (gen + 1u) * nloc) {
            __builtin_amdgcn_fence(__ATOMIC_RELEASE, "agent");
            asm volatile("s_waitcnt vmcnt(0)" ::: "memory");
            const unsigned og = xb_add(&bar[XB_TOP], 1u);
            const unsigned tg = og / nx;
            if (og + 1u == (tg + 1u) * nx) xb_add(&bar[XB_TOPGEN], 1u);
            else XB_SPIN(xb_ld(&bar[XB_TOPGEN]) == tg, bar);
            __builtin_amdgcn_fence(__ATOMIC_ACQUIRE, "agent");
            xb_add(&bar[XB_XGEN(b.x)], 1u);
            asm volatile("s_waitcnt vmcnt(0)" ::: "memory");
        } else {
            XB_SPIN(xb_ld(&bar[XB_XGEN(b.x)]) == gen, bar);
            __builtin_amdgcn_fence(__ATOMIC_ACQUIRE, "agent");
            asm volatile("s_waitcnt vmcnt(0)" ::: "memory");
        }
    }
    __syncthreads();
}
__device__ __forceinline__ int permE(int n0) {
    if (n0 < 512) return (n0 >> 7) * 256 + (n0 & 127);
    if (n0 < 1024) return ((n0 - 512) >> 7) * 256 + 128 + ((n0 - 512) & 127);
    return n0;
}
__device__ __forceinline__ void tr_item(const float* W, int K, int N, bf16* WT, bool perm, LAS float* scr, int item, int lane) {
    const int nblk = N >> 5, kb = item / nblk, nb = item - kb * nblk, k0 = 64 * kb, n0 = 32 * nb, d0 = perm ? permE(n0) : n0;
#pragma unroll 8
    for (int i = 0; i < 32; ++i) { const int kk = 2 * i + (lane >> 5); scr[kk * 33 + (lane & 31)] = W[(size_t)(k0 + kk) * N + n0 + (lane & 31)]; }
    LDS_WAIT(); asm volatile("" ::: "memory");
    const int c = lane & 7;
#pragma unroll
    for (int j = 0; j < 4; ++j) { const int n = (lane >> 3) + 8 * j; const LAS float* s = scr + (8 * c) * 33 + n;
        v4u o; o.x = pk2(s[0 * 33], s[1 * 33]); o.y = pk2(s[2 * 33], s[3 * 33]); o.z = pk2(s[4 * 33], s[5 * 33]); o.w = pk2(s[6 * 33], s[7 * 33]);
        *(v4u*)(WT + (size_t)(d0 + n) * K + k0 + 8 * c) = o; }
    LDS_WAIT(); asm volatile("" ::: "memory");
}
__device__ __forceinline__ void prologue_phase(const Args& a, LAS unsigned char* lds, int bid, int G) {
    int tid = threadIdx.x; asm volatile("" : "+v"(tid)); const int lane = tid & 63, wave = __builtin_amdgcn_readfirstlane(tid >> 6), gw = bid * NWAVES + wave, NGW = G * NWAVES;
    unsigned char* ws = a.ws;
    LAS float* scr = (LAS float*)(lds + wave * 16384);
    constexpr int C_ADA = 16 * 192, C_INE = 16 * 48, C_SQ = 16 * 32, C_INO = 16 * 64, C_F1 = 16 * 128, C_F2 = 64 * 32, C_PL = 2 * 4;
    constexpr int NITEMS = 4 * C_ADA + 2 * C_INE + 2 * C_SQ + 2 * C_INO + 2 * C_SQ + 4 * C_F1 + 4 * C_F2 + 8 * C_PL;
    for (int it = gw; it < NITEMS; it += NGW) {
        int r = it;
        if (r < 4 * C_ADA) { const int l = r / C_ADA; tr_item(a.in[I_WADA] + (size_t)l * D * 6 * D, D, 6 * D, (bf16*)(ws + WS_WADA) + (size_t)l * 6 * D * D, false, scr, r - l * C_ADA, lane); continue; } r -= 4 * C_ADA;
        if (r < 2 * C_INE) { const int l = r / C_INE; tr_item(a.in[I_WINAB] + (size_t)l * D * NZ_E, D, NZ_E, (bf16*)(ws + WS_WINE) + (size_t)l * NZ_E * D, true, scr, r - l * C_INE, lane); continue; } r -= 2 * C_INE;
        if (r < 2 * C_SQ) { const int l = r / C_SQ; tr_item(a.in[I_WOUTAB] + (size_t)l * D * D, D, D, (bf16*)(ws + WS_WOUTE) + (size_t)l * D * D, false, scr, r - l * C_SQ, lane); continue; } r -= 2 * C_SQ;
        if (r < 2 * C_INO) { const int l = r / C_INO; tr_item(a.in[I_WINC] + (size_t)l * D * NZ_O, D, NZ_O, (bf16*)(ws + WS_WINO) + (size_t)l * NZ_O * D, false, scr, r - l * C_INO, lane); continue; } r -= 2 * C_INO;
        if (r < 2 * C_SQ) { const int l = r / C_SQ; tr_item(a.in[I_WOUTC] + (size_t)l * D * D, D, D, (bf16*)(ws + WS_WOUTO) + (size_t)l * D * D, false, scr, r - l * C_SQ, lane); continue; } r -= 2 * C_SQ;
        if (r < 4 * C_F1) { const int l = r / C_F1; tr_item(a.in[I_WFFN1] + (size_t)l * D * FF, D, FF, (bf16*)(ws + WS_W1) + (size_t)l * FF * D, false, scr, r - l * C_F1, lane); continue; } r -= 4 * C_F1;
        if (r < 4 * C_F2) { const int l = r / C_F2; tr_item(a.in[I_WFFN2] + (size_t)l * FF * D, FF, D, (bf16*)(ws + WS_W2) + (size_t)l * D * FF, false, scr, r - l * C_F2, lane); continue; } r -= 4 * C_F2;
        { const int l = r / C_PL; tr_item(a.in[I_WPOOL] + (size_t)l * 128 * 128, 128, 128, (bf16*)(ws + WS_WPOOL) + (size_t)l * 128 * 128, false, scr, r - l * C_PL, lane); }
    }
    const int gt = gw * 64 + lane, NGT = NGW * 64;
    for (int i = gt; i < 256 * D / 4; i += NGT) { const int r = i >> 8, k = (i & 255) * 4; v2u o; o.x = 0u; o.y = 0u;
        if (r < NMODROWS) { const float* c = (r < NB_P ? a.in[I_CP] + (size_t)r * D : a.in[I_CS] + (size_t)(r - NB_P) * D) + k; const f32x4 v = *(const f32x4*)c;
            o.x = pk2(silu_f(v.x), silu_f(v.y)); o.y = pk2(silu_f(v.z), silu_f(v.w)); }
        *(v2u*)((bf16*)(ws + WS_CSILU) + (size_t)r * D + k) = o; }
    for (int i = gt; i < 2 * HC * CHUNK * CHUNK / 4; i += NGT) { const int e = i * 4, s = e & 127, t = (e >> 7) & 127; const f32x4 v = *(const f32x4*)(a.in[I_WSP] + e);
        v2u o; o.x = pk2(s <= t ? v.x : 0.f, s + 1 <= t ? v.y : 0.f); o.y = pk2(s + 2 <= t ? v.z : 0.f, s + 3 <= t ? v.w : 0.f);
        *(v2u*)((bf16*)(ws + WS_WSP) + e) = o; }
}
template <bool FINAL>
__device__ __forceinline__ void norm_phase(const float* xp, const float* xs, const float* g, const float* modl, int i_shift, int i_scale, bf16* H, float* out, int bid, int G) {
    int tid = threadIdx.x; asm volatile("" : "+v"(tid)); const int lane = tid & 63, wave = __builtin_amdgcn_readfirstlane(tid >> 6), gw = bid * NWAVES + wave, NGW = G * NWAVES;
    for (int r = gw; r < M; r += NGW) {
        const float* x = (r < MP ? xp + (size_t)r * D : xs + (size_t)(r - MP) * D) + 4 * lane;
        f32x4 v[4]; float ss = 0.f;
#pragma unroll
        for (int j = 0; j < 4; ++j) { v[j] = *(const f32x4*)(x + 256 * j); ss += (v[j].x * v[j].x + v[j].y * v[j].y) + (v[j].z * v[j].z + v[j].w * v[j].w); }
        const float rstd = rsqrtf(wave_sum(ss) * (1.0f / D) + EPS);
        if (FINAL) {
#pragma unroll
            for (int j = 0; j < 4; ++j) { const int k = 4 * lane + 256 * j; const f32x4 gg = *(const f32x4*)(g + k); *(f32x4*)(out + (size_t)r * D + k) = v[j] * rstd * gg; }
        } else {
            const float* mrow = modl + (size_t)modrow_of(r) * MODLD;
#pragma unroll
            for (int j = 0; j < 4; ++j) { const int k = 4 * lane + 256 * j; const f32x4 gg = *(const f32x4*)(g + k), sc = *(const f32x4*)(mrow + i_scale * D + k), sh = *(const f32x4*)(mrow + i_shift * D + k);
                const f32x4 y = v[j] * rstd * gg * (sc + 1.0f) + sh; v2u o; o.x = pk2(y.x, y.y); o.y = pk2(y.z, y.w); *(v2u*)(H + (size_t)r * D + k) = o; }
        }
    }
}
__device__ __forceinline__ v4u pack8(const f32x4 a, const f32x4 b) { v4u w; w.x = pk2(a.x, a.y); w.y = pk2(a.z, a.w); w.z = pk2(b.x, b.y); w.w = pk2(b.z, b.w); return w; }

constexpr int MX_DOFF = 49152, MX_DROW = 1040, MX_RED = 86016, MX_STAT = 88064;
__device__ __forceinline__ void mix_even_phase(LAS unsigned char* lds, int i, const bf16* Z, bf16* CAT, const float* sconv, const float* spool, const float* w_dw, const float* b_dw,
                                               const float* g_cln, const float* b_cln, const bf16* wpool_t, const float* s_pool, float* out, int bid, int G) {
    int tid = threadIdx.x; asm volatile("" : "+v"(tid)); const int lane = tid & 63, wave = __builtin_amdgcn_readfirstlane(tid >> 6);
    for (int it = bid; it < 640; it += G) {
        int b, t0, ntok, s0; bool samp;
        if (it < 512) { b = it >> 6; t0 = (it & 63) << 5; ntok = 32; s0 = b * T_P; samp = false; }
        else { b = it - 512; t0 = 0; ntok = T_S; s0 = MP + b * T_S; samp = true; }
        const bool last = (!samp) && (t0 == T_P - 32);
        { const int ch = tid & 63;
          for (int e = tid >> 6; e < NHIST_P + ntok; e += 8) { const int tt = t0 - NHIST_P + e; v4u w = (v4u){0u, 0u, 0u, 0u};
              if (tt >= 0) w = *(const v4u*)(Z + (size_t)(s0 + tt) * D + 512 + 8 * ch);
              else if (samp) { const float* hp = spool + ((size_t)b * NHIST_P + (NHIST_P + tt)) * DB + 8 * ch; w = pack8(*(const f32x4*)hp, *(const f32x4*)(hp + 4)); }
              *(LAS v4u*)(lds + e * 1024 + 16 * ch) = w; } }
        __syncthreads();
        { const int c = tid, g = c >> 7, w = 2 << g; const LAS bf16* P = (const LAS bf16*)lds; LAS bf16* Ds = (LAS bf16*)(lds + MX_DOFF);
          for (int t = 0; t < 32; ++t) { float s = 0.f;
              for (int k = 0; k < w; ++k) s += bf1(P[(NHIST_P + t - k) * 512 + c]);
              const int pos = (samp ? PAST : 0) + t0 + t + 1; const float cnt = (float)(w < pos ? w : pos);
              Ds[t * (MX_DROW / 2) + c] = (bf16)f2bf(s / cnt - bf1(P[(NHIST_P + t) * 512 + c])); }
          if (last) { for (int t = 17; t < 32; ++t) out[O_NPP + (((size_t)i * NB_P + b) * NHIST_P + (t - 17)) * DB + c] = bf1(P[(NHIST_P + t) * 512 + c]); }
          if (samp) { for (int j = 0; j < NHIST_P; ++j) out[O_NPS + (((size_t)i * NB_S + b) * NHIST_P + j) * DB + c] = j < 11 ? spool[((size_t)b * NHIST_P + j + 4) * DB + c] : bf1(P[(NHIST_P + j - 11) * 512 + c]); } }
        __syncthreads();
        { const int g = wave >> 1, fr = lane & 15, fq = lane >> 4; f32x4 acc[2][4];
#pragma unroll
          for (int mi = 0; mi < 2; ++mi)
#pragma unroll
              for (int ni = 0; ni < 4; ++ni) acc[mi][ni] = (f32x4){0.f, 0.f, 0.f, 0.f};
          const bf16* wp = wpool_t + ((size_t)g * 128 + 64 * (wave & 1)) * 128;
#pragma unroll
          for (int kk = 0; kk < 4; ++kk) { bf16x8 bfr[2], afr[4];
#pragma unroll
              for (int mi = 0; mi < 2; ++mi) bfr[mi] = *(const LAS bf16x8*)(lds + MX_DOFF + (16 * mi + fr) * MX_DROW + (g * 128 + 32 * kk + 8 * fq) * 2);
#pragma unroll
              for (int ni = 0; ni < 4; ++ni) afr[ni] = *(const bf16x8*)(wp + (size_t)(16 * ni + fr) * 128 + 32 * kk + 8 * fq);
#pragma unroll
              for (int mi = 0; mi < 2; ++mi)
#pragma unroll
                  for (int ni = 0; ni < 4; ++ni) acc[mi][ni] = __builtin_amdgcn_mfma_f32_16x16x32_bf16(afr[ni], bfr[mi], acc[mi][ni], 0, 0, 0); }
#pragma unroll
          for (int mi = 0; mi < 2; ++mi) { const int t = 16 * mi + fr;
              if (t < ntok) {
#pragma unroll
                  for (int ni = 0; ni < 4; ++ni) { const int col = 64 * wave + 16 * ni + 4 * fq; const f32x4 sp = *(const f32x4*)(s_pool + col), y = acc[mi][ni] * sp;
                      v2u o; o.x = pk2(y.x, y.y); o.y = pk2(y.z, y.w); *(v2u*)(CAT + (size_t)(s0 + t0 + t) * D + 512 + col) = o; } } } }
        __syncthreads();
        { const int ch = tid & 63;
          for (int e = tid >> 6; e < NHIST_C + ntok; e += 8) { const int tt = t0 - NHIST_C + e; v4u w = (v4u){0u, 0u, 0u, 0u};
              if (tt >= 0) w = *(const v4u*)(Z + (size_t)(s0 + tt) * D + 8 * ch);
              else if (samp) { const float* hp = sconv + ((size_t)b * NHIST_C + (NHIST_C + tt)) * DA + 8 * ch; w = pack8(*(const f32x4*)hp, *(const f32x4*)(hp + 4)); }
              *(LAS v4u*)(lds + e * 1024 + 16 * ch) = w; } }
        __syncthreads();
        { const int c = tid; const LAS bf16* A = (const LAS bf16*)lds; LAS float* RED = (LAS float*)(lds + MX_RED); LAS float* STAT = (LAS float*)(lds + MX_STAT);
          float wv[CONVW], av[62], cv[32];
#pragma unroll
          for (int j = 0; j < CONVW; ++j) wv[j] = w_dw[j * DA + c];
#pragma unroll
          for (int e = 0; e < 62; ++e) av[e] = bf1(A[e * 512 + c]);
          const float bias = b_dw[c];
#pragma unroll
          for (int t = 0; t < 32; ++t) { float acc = bias;
#pragma unroll
              for (int j = 0; j < CONVW; ++j) acc += wv[j] * av[t + j];
              cv[t] = acc; }
#pragma unroll
          for (int t = 0; t < 32; ++t) { const float s = wave_sum(cv[t]), q = wave_sum(cv[t] * cv[t]); if (lane == 0) { RED[(wave * 32 + t) * 2] = s; RED[(wave * 32 + t) * 2 + 1] = q; } }
          __syncthreads();
          if (tid < 32) { float s = 0.f, q = 0.f;
#pragma unroll
              for (int w = 0; w < 8; ++w) { s += RED[(w * 32 + tid) * 2]; q += RED[(w * 32 + tid) * 2 + 1]; }
              const float mean = s * (1.0f / DA), var = fmaxf(q * (1.0f / DA) - mean * mean, 0.f); STAT[tid * 2] = mean; STAT[tid * 2 + 1] = rsqrtf(var + EPS); }
          __syncthreads();
          const float gc = g_cln[c], bc = b_cln[c];
#pragma unroll
          for (int t = 0; t < 32; ++t) if (t < ntok) { const float y = (cv[t] - STAT[t * 2]) * STAT[t * 2 + 1] * gc + bc; CAT[(size_t)(s0 + t0 + t) * D + c] = (bf16)f2bf(silu_f(y)); }
          if (last) {
#pragma unroll
              for (int t = 2; t < 32; ++t) out[O_NCP + (((size_t)i * NB_P + b) * NHIST_C + (t - 2)) * DA + c] = av[30 + t]; }
          if (samp) {
#pragma unroll
              for (int j = 0; j < NHIST_C; ++j) out[O_NCS + (((size_t)i * NB_S + b) * NHIST_C + j) * DA + c] = j < 26 ? sconv[((size_t)b * NHIST_C + j + 4) * DA + c] : av[30 + (j - 26)]; } }
        __syncthreads();
    }
}

__device__ __forceinline__ unsigned off_b(unsigned row, unsigned ch) { return 256u * row + 16u * (ch ^ (((row & 3) << 2) | ((row >> 2) & 3))); }
__device__ __forceinline__ unsigned tr_addr16(unsigned lane, unsigned c, unsigned ks, unsigned t) { const unsigned g = lane >> 4, q = (lane & 15) >> 2, p = lane & 3; return off_b(32 * ks + 8 * g + 4 * t + q, 2 * c + (p >> 1)) + 8 * (p & 1); }
__device__ __forceinline__ s16x4 tr_read(LAS unsigned char* p) { return __builtin_bit_cast(s16x4, __builtin_amdgcn_ds_read_tr16_b64_v4i16((LAS s16x4*)p)); }
__device__ __forceinline__ void mix_odd_phase(LAS unsigned char* lds, int j, const bf16* U, const bf16* V, const float* vstat, bf16* Y, const float* g_v, const float* b_v, const bf16* wsbf,
                                              const float* w_sp, const float* b_sp, float* out, int bid, int G) {
    int tid = threadIdx.x; asm volatile("" : "+v"(tid)); const int lane = tid & 63, wave = __builtin_amdgcn_readfirstlane(tid >> 6);
    for (int it = bid; it < 1024 + NB_S; it += G) {
        if (it < 1024) {
            const int ck = it >> 3, h = it & 7, row0 = ck * CHUNK;
            { const int s = tid >> 2, q = tid & 3, row = row0 + s; const f32x4* sp = (const f32x4*)(vstat + (size_t)row * 32); float S = 0.f, Q = 0.f;
#pragma unroll
              for (int k = 0; k < 8; ++k) { const f32x4 v = sp[k]; S += v.x + v.z; Q += v.y + v.w; }
              const float mean = S * (1.0f / D), rstd = rsqrtf(fmaxf(Q * (1.0f / D) - mean * mean, 0.f) + EPS);
#pragma unroll
              for (int cc = 0; cc < 4; ++cc) { const int ch = 4 * q + cc, c0 = 128 * h + 8 * ch; const v4u w = *(const v4u*)(V + (size_t)row * D + c0);
                  const f32x4 g0 = *(const f32x4*)(g_v + c0), g1 = *(const f32x4*)(g_v + c0 + 4), b0 = *(const f32x4*)(b_v + c0), b1 = *(const f32x4*)(b_v + c0 + 4);
                  f32x4 x0 = (f32x4){bflo(w.x), bfhi(w.x), bflo(w.y), bfhi(w.y)}, x1 = (f32x4){bflo(w.z), bfhi(w.z), bflo(w.w), bfhi(w.w)};
                  x0 = (x0 - mean) * rstd * g0 + b0; x1 = (x1 - mean) * rstd * g1 + b1;
                  *(LAS v4u*)(lds + off_b(s, ch)) = pack8(x0, x1); } }
            __syncthreads();
            { const int fr = lane & 15, fq = lane >> 4, t = 16 * wave + fr, nks = (wave >> 1) + 1; f32x4 acc[8];
#pragma unroll
              for (int cb = 0; cb < 8; ++cb) acc[cb] = (f32x4){0.f, 0.f, 0.f, 0.f};
              const bf16* wsrow = wsbf + ((size_t)h * CHUNK + t) * CHUNK;
              for (int ks = 0; ks < nks; ++ks) { const bf16x8 bfr = *(const bf16x8*)(wsrow + 32 * ks + 8 * fq);
#pragma unroll
                  for (int cb = 0; cb < 8; ++cb) { const s16x4 lo = tr_read(lds + tr_addr16(lane, cb, ks, 0)), hi = tr_read(lds + tr_addr16(lane, cb, ks, 1));
                      const bf16x8 afr = (bf16x8){lo[0], lo[1], lo[2], lo[3], hi[0], hi[1], hi[2], hi[3]};
                      acc[cb] = __builtin_amdgcn_mfma_f32_16x16x32_bf16(afr, bfr, acc[cb], 0, 0, 0); } }
              const float bs = b_sp[h * CHUNK + t];
#pragma unroll
              for (int cb = 0; cb < 8; ++cb) { const size_t o = (size_t)(row0 + t) * D + 128 * h + 16 * cb + 4 * fq; const v2u uu = *(const v2u*)(U + o);
                  v2u y; y.x = pk2(bflo(uu.x) * (acc[cb].x + bs), bfhi(uu.x) * (acc[cb].y + bs)); y.y = pk2(bflo(uu.y) * (acc[cb].z + bs), bfhi(uu.y) * (acc[cb].w + bs)); *(v2u*)(Y + o) = y; } }
            __syncthreads();
        } else {
            const int b = it - 1024, r0 = MP + T_S * b; LAS float* ST = (LAS float*)(lds + 32768);
            if (tid < T_S) { const f32x4* sp = (const f32x4*)(vstat + (size_t)(r0 + tid) * 32); float S = 0.f, Q = 0.f;
#pragma unroll
                for (int k = 0; k < 8; ++k) { const f32x4 v = sp[k]; S += v.x + v.z; Q += v.y + v.w; }
                const float mean = S * (1.0f / D); ST[2 * tid] = mean; ST[2 * tid + 1] = rsqrtf(fmaxf(Q * (1.0f / D) - mean * mean, 0.f) + EPS); }
            __syncthreads();
            { const int c = 2 * tid, h = c >> 7; const f32x2 gg = *(const f32x2*)(g_v + c), bb = *(const f32x2*)(b_v + c); float vn[T_S][2];
#pragma unroll
              for (int s = 0; s < T_S; ++s) { const unsigned w = *(const unsigned*)(V + (size_t)(r0 + s) * D + c); const float mean = ST[2 * s], rstd = ST[2 * s + 1];
                  vn[s][0] = (bflo(w) - mean) * rstd * gg.x + bb.x; vn[s][1] = (bfhi(w) - mean) * rstd * gg.y + bb.y;
                  f32x2 o; o.x = vn[s][0]; o.y = vn[s][1]; *(f32x2*)(out + O_NV + ((size_t)j * MS + T_S * b + s) * D + c) = o; }
#pragma unroll
              for (int t = 0; t < T_S; ++t) { const float bs = b_sp[h * CHUNK + t]; float a0 = bs, a1 = bs;
#pragma unroll
                  for (int s = 0; s <= t; ++s) { const float wgt = w_sp[((size_t)h * CHUNK + t) * CHUNK + s]; a0 += wgt * vn[s][0]; a1 += wgt * vn[s][1]; }
                  const unsigned uu = *(const unsigned*)(U + (size_t)(r0 + t) * D + c); *(unsigned*)(Y + (size_t)(r0 + t) * D + c) = pk2(bflo(uu) * a0, bfhi(uu) * a1); } }
            __syncthreads();
        }
    }
}
#define GRID_SYNC() xcd_barrier(bar)
#define GEMM_PHASE(EpiT, Aptr, Bptr, Mv, Nv, Kv, Eobj) do { pg8::Gemm g_{(const pg8::bf16_t*)(Aptr), (const pg8::bf16_t*)(Bptr), (Mv), (Nv), (Kv)}; pg8::StaticOrder S_; S_.init((Mv), (Nv), G, bid); \
    pg8::gemm_phase<EpiT, pg8::StaticOrder, true, true>(lds, g_, S_, (Eobj)); } while (0)

__global__ void __launch_bounds__(NTHREADS, 2) mega_fwd(Args a) {
    extern __shared__ __attribute__((aligned(16))) unsigned char lds_raw[];
    LAS unsigned char* lds = (LAS unsigned char*)lds_raw;
    volatile LAS unsigned* MISC = (volatile LAS unsigned*)(lds + 131072 + 64);
    if (threadIdx.x < 2) MISC[threadIdx.x] = 0u;
    __syncthreads();
    const XcdBarrier bar = xcd_barrier_post((unsigned*)(a.ws + WS_CTL), MISC);
    constexpr int NPH = 3 + 7 * DEPTH;
    for (int ph = 0; ph < NPH; ++ph) {
        int p = ph, G = gridDim.x, bid = blockIdx.x; asm volatile("" : "+s"(p), "+s"(G), "+s"(bid));
        unsigned char* ws = a.ws; float* out = a.out;
        float* MODG = (float*)(ws + WS_MODG); float* X = (float*)(ws + WS_X); bf16* H = (bf16*)(ws + WS_H);
        bf16* Z0 = (bf16*)(ws + WS_Z0); bf16* Z1 = (bf16*)(ws + WS_Z1); bf16* CAT = (bf16*)(ws + WS_CAT); bf16* HID = (bf16*)(ws + WS_HID); float* VSTAT = (float*)(ws + WS_VSTAT);
        if (p == 0) {
            prologue_phase(a, lds, bid, G);
        } else if (p == 1) {
            pg8::EpiMod E{MODG, a.in[I_BADA]}; GEMM_PHASE(pg8::EpiMod, ws + WS_CSILU, ws + WS_WADA, 256, MODLD, D, E);
        } else {
            const int qq = p + 4, l = qq / 7 - 1, k = qq - 7 * (l + 1), half = l >> 1; const bool even = (l & 1) == 0;
            const float* modl = MODG + (size_t)l * 6 * D;
            if (k == 0) {
                if (even) { pg8::EpiGlu E{Z0}; GEMM_PHASE(pg8::EpiGlu, H, (bf16*)(ws + WS_WINE) + (size_t)half * NZ_E * D, M, NZ_E, D, E); }
                else { pg8::EpiUV E{Z0, Z1, VSTAT}; GEMM_PHASE(pg8::EpiUV, H, (bf16*)(ws + WS_WINO) + (size_t)half * NZ_O * D, M, NZ_O, D, E); }
            } else if (k == 1) {
                if (even) mix_even_phase(lds, half, Z0, CAT, a.in[I_SCONV] + (size_t)half * NB_S * NHIST_C * DA, a.in[I_SPOOL] + (size_t)half * NB_S * NHIST_P * DB, a.in[I_WDW] + (size_t)half * CONVW * DA, a.in[I_BDW] + (size_t)half * DA,
                                         a.in[I_GCLN] + (size_t)half * DA, a.in[I_BCLN] + (size_t)half * DA, (bf16*)(ws + WS_WPOOL) + (size_t)half * 4 * 128 * 128, a.in[I_SPOOLS] + (size_t)half * DB, out, bid, G);
                else mix_odd_phase(lds, half, Z0, Z1, VSTAT, CAT, a.in[I_GV] + (size_t)half * D, a.in[I_BV] + (size_t)half * D, (bf16*)(ws + WS_WSP) + (size_t)half * HC * CHUNK * CHUNK,
                                   a.in[I_WSP] + (size_t)half * HC * CHUNK * CHUNK, a.in[I_BSP] + (size_t)half * HC * CHUNK, out, bid, G);
            } else if (k == 2 || k == 5) {
                const bool mixer = (k == 2), first = mixer && l == 0;
                const bf16* A = mixer ? CAT : HID;
                const bf16* Bt = mixer ? (even ? (bf16*)(ws + WS_WOUTE) : (bf16*)(ws + WS_WOUTO)) + (size_t)half * D * D : (bf16*)(ws + WS_W2) + (size_t)l * D * FF;
                pg8::EpiRes E{first ? a.in[I_XP] : X, first ? a.in[I_XS] : X + (size_t)MP * D, X, modl + (mixer ? 2 : 5) * D};
                GEMM_PHASE(pg8::EpiRes, A, Bt, M, D, mixer ? D : FF, E);
            } else if (k == 4) {
                pg8::EpiRelu2 E{HID}; GEMM_PHASE(pg8::EpiRelu2, H, (bf16*)(ws + WS_W1) + (size_t)l * FF * D, M, FF, D, E);
            } else if (k == 6 && l == DEPTH - 1) {
                norm_phase<true>(X, X + (size_t)MP * D, a.in[I_GFINAL], nullptr, 0, 0, nullptr, out + O_YP, bid, G);
            } else {
                const bool nxt = (k == 6), fromin = nxt && l < 0;
                norm_phase<false>(fromin ? a.in[I_XP] : X, fromin ? a.in[I_XS] : X + (size_t)MP * D, nxt ? a.in[I_GMIX] + (size_t)(l + 1) * D : a.in[I_GFFN] + (size_t)l * D,
                                  nxt ? modl + 6 * D : modl, nxt ? 0 : 3, nxt ? 1 : 4, H, nullptr, bid, G);
            }
        }
        if (ph < NPH - 1) GRID_SYNC();
    }
}

extern "C" void kernel_launch(void* const* d_in, const int* in_sizes, int n_in, void* d_out, int out_size, void* d_ws, size_t ws_size, hipStream_t stream) {
    static int grid = 0;
    if (grid == 0) {
        if (n_in != N_INPUTS || (size_t)out_size != O_END || ws_size < WS_END) { fprintf(stderr, "kernel_launch: unexpected shapes: n_in %d out %d ws %zu (need %zu)\n", n_in, out_size, ws_size, (size_t)WS_END); grid = -1; return; }
        int dev = 0, cus = 0, per_cu = 0;
        if (hipGetDevice(&dev) != hipSuccess || hipDeviceGetAttribute(&cus, hipDeviceAttributeMultiprocessorCount, dev) != hipSuccess) { grid = -1; return; }
        if (hipFuncSetAttribute((const void*)mega_fwd, hipFuncAttributeMaxDynamicSharedMemorySize, LDS_BYTES) != hipSuccess) { fprintf(stderr, "kernel_launch: hipFuncSetAttribute failed\n"); grid = -1; return; }
        if (hipOccupancyMaxActiveBlocksPerMultiprocessor(&per_cu, (const void*)mega_fwd, NTHREADS, LDS_BYTES) != hipSuccess || per_cu < 1) { fprintf(stderr, "kernel_launch: occupancy query says %d blocks per CU\n", per_cu); grid = -1; (void)hipGetLastError(); return; }
        grid = cus;
    }
    if (grid < 0) return;
    if (hipMemsetAsync((char*)d_ws + WS_CTL, 0, 16384, stream) != hipSuccess) { fprintf(stderr, "kernel_launch: hipMemsetAsync failed\n"); return; }
    Args a{};
    for (int i = 0; i < N_INPUTS; ++i) a.in[i] = (const float*)d_in[i];
    a.out = (float*)d_out; a.ws = (unsigned char*)d_ws;
    void* args[] = {&a};
    hipError_t e = hipLaunchCooperativeKernel((const void*)mega_fwd, dim3(grid), dim3(NTHREADS), args, LDS_BYTES, stream);
    if (e != hipSuccess) fprintf(stderr, "kernel_launch: cooperative launch failed: %s (grid %d)\n", hipGetErrorString(e), grid);
}
```
